# Optimizing an MI355X kernel written in HIP

```python
import jax, jax.numpy as jnp
from jax import lax
import numpy as np

D_MODEL = 1024
BATCH = 1
SEQ = 16384
DEPTH = 1
DEC_BATCH = 32
DEC_SEQ = 64
PAST_LEN = 1024

CHUNK = 64
HEAD_DIM = 64
MIX_WIDTH = D_MODEL
EPS = 1e-6
SCALE = HEAD_DIM ** -0.5
NEG = -1e30
A_HEADS = 8
A_LEFT_CHUNKS = 8
A_BAND = A_LEFT_CHUNKS + 1
A_CTX = A_LEFT_CHUNKS * CHUNK
MAX_REL = 128
A_WIDTH = A_HEADS * HEAD_DIM
B_HEADS = 8
B_KV_HEADS = 2
B_GROUP = B_HEADS // B_KV_HEADS
WINDOW = 128
B_LEFT_CHUNKS = WINDOW // CHUNK
B_BAND = B_LEFT_CHUNKS + 1
B_CTX = WINDOW
B_WIDTH = B_HEADS * HEAD_DIM
B_KV_WIDTH = B_KV_HEADS * HEAD_DIM
ROPE_THETA = 10000.0
IN_COLS = 3 * A_WIDTH + B_WIDTH + 2 * B_KV_WIDTH
IN_SPLITS = [A_WIDTH, 2 * A_WIDTH, 3 * A_WIDTH, 3 * A_WIDTH + B_WIDTH, 3 * A_WIDTH + B_WIDTH + B_KV_WIDTH]
D_FF = 2816
CONV_W = 3

kernel_name = "hybrid_chunkband_swa_sink_convffn_step"


def rms_norm(x, g):
    xf = x.astype(jnp.float32)
    y = xf * lax.rsqrt(jnp.mean(xf * xf, axis=-1, keepdims=True) + EPS)
    return (y * g.astype(jnp.float32)).astype(x.dtype)


def rope(x, pos):
    half = HEAD_DIM // 2
    inv = jnp.power(ROPE_THETA, -jnp.arange(half, dtype=jnp.float32) / half)
    ang = pos.astype(jnp.float32)[:, None] * inv[None, :]
    cos = jnp.cos(ang)[:, None, :]
    sin = jnp.sin(ang)[:, None, :]
    x1 = x[..., :half].astype(jnp.float32)
    x2 = x[..., half:].astype(jnp.float32)
    return jnp.concatenate([x1 * cos - x2 * sin, x2 * cos + x1 * sin], axis=-1).astype(x.dtype)


def project_heads(h, pos, w_in, q_norm_a, k_norm_a, q_norm_b, k_norm_b):
    bsz, s, _ = h.shape
    p = jnp.einsum("bsd,dc->bsc", h, w_in)
    qa, ka, va, qb, kb, vb = jnp.split(p, IN_SPLITS, axis=-1)
    qa = rms_norm(qa.reshape(bsz, s, A_HEADS, HEAD_DIM), q_norm_a)
    ka = rms_norm(ka.reshape(bsz, s, A_HEADS, HEAD_DIM), k_norm_a)
    va = va.reshape(bsz, s, A_HEADS, HEAD_DIM)
    qb = rope(rms_norm(qb.reshape(bsz, s, B_HEADS, HEAD_DIM), q_norm_b), pos)
    kb = rope(rms_norm(kb.reshape(bsz, s, B_KV_HEADS, HEAD_DIM), k_norm_b), pos)
    vb = vb.reshape(bsz, s, B_KV_HEADS, HEAD_DIM)
    return qa, ka, va, qb, kb, vb


def rel_bias(table, qpos, kpos):
    d = jnp.clip(qpos[:, None] - kpos[None, :], -MAX_REL, MAX_REL) + MAX_REL
    return table[:, d].astype(jnp.float32)


def band_gather(x, n_left):
    bsz, s, nh, d = x.shape
    nc = s // CHUNK
    xc = x.reshape(bsz, nc, CHUNK, nh, d)
    xp = jnp.pad(xc, ((0, 0), (n_left, 0), (0, 0), (0, 0), (0, 0)))
    idx = jnp.arange(nc)[:, None] + jnp.arange(n_left + 1)[None, :]
    return xp[:, idx].reshape(bsz, nc, (n_left + 1) * CHUNK, nh, d)


def band_valid(nc, n_left):
    kchunk = jnp.arange((n_left + 1) * CHUNK) // CHUNK
    return (jnp.arange(nc)[:, None] - n_left + kchunk[None, :]) >= 0


def sink_softmax(scores, sinks):
    s = sinks.astype(jnp.float32).reshape(B_KV_HEADS, B_GROUP, 1, 1)
    m = jnp.maximum(jnp.max(scores, axis=-1, keepdims=True), s)
    e = jnp.exp(scores - m)
    return e / (jnp.sum(e, axis=-1, keepdims=True) + jnp.exp(s - m))


def band_attn_a_prompt(q, k, v, rel_table):
    bsz, s, nh, d = q.shape
    nc = s // CHUNK
    qc = q.reshape(bsz, nc, CHUNK, nh, d)
    kb = band_gather(k, A_LEFT_CHUNKS)
    vb = band_gather(v, A_LEFT_CHUNKS)
    scores = jnp.einsum("bnqhd,bnkhd->bnhqk", qc, kb, preferred_element_type=jnp.float32) * SCALE
    bias = rel_bias(rel_table, A_LEFT_CHUNKS * CHUNK + jnp.arange(CHUNK), jnp.arange(A_BAND * CHUNK))
    valid = band_valid(nc, A_LEFT_CHUNKS)
    scores = jnp.where(valid[None, :, None, None, :], scores + bias[None, None], NEG)
    p = jax.nn.softmax(scores, axis=-1)
    out = jnp.einsum("bnhqk,bnkhd->bnqhd", p.astype(v.dtype), vb)
    return out.reshape(bsz, s, A_WIDTH)


def band_attn_a_sample(q, k_new, v_new, k_cache, v_cache, rel_table):
    bsz, t = q.shape[:2]
    past = k_cache.shape[1]
    k = jnp.concatenate([k_cache.astype(k_new.dtype), k_new], axis=1)
    v = jnp.concatenate([v_cache.astype(v_new.dtype), v_new], axis=1)
    scores = jnp.einsum("bqhd,bkhd->bhqk", q, k, preferred_element_type=jnp.float32) * SCALE
    scores = scores + rel_bias(rel_table, past + jnp.arange(t), jnp.arange(past + t))[None]
    p = jax.nn.softmax(scores, axis=-1)
    out = jnp.einsum("bhqk,bkhd->bqhd", p.astype(v.dtype), v)
    return out.reshape(bsz, t, A_WIDTH)


def window_attn_b_prompt(q, k, v, sinks):
    bsz, s = q.shape[:2]
    nc = s // CHUNK
    qc = q.reshape(bsz, nc, CHUNK, B_KV_HEADS, B_GROUP, HEAD_DIM)
    kb = band_gather(k, B_LEFT_CHUNKS)
    vb = band_gather(v, B_LEFT_CHUNKS)
    scores = jnp.einsum("bnqgrd,bnkgd->bngrqk", qc, kb, preferred_element_type=jnp.float32) * SCALE
    valid = band_valid(nc, B_LEFT_CHUNKS)
    scores = jnp.where(valid[None, :, None, None, None, :], scores, NEG)
    p = sink_softmax(scores, sinks)
    out = jnp.einsum("bngrqk,bnkgd->bnqgrd", p.astype(v.dtype), vb)
    return out.reshape(bsz, s, B_WIDTH)


def window_attn_b_sample(q, k_new, v_new, k_cache, v_cache, sinks):
    bsz, t = q.shape[:2]
    k = jnp.concatenate([k_cache.astype(k_new.dtype), k_new], axis=1)
    v = jnp.concatenate([v_cache.astype(v_new.dtype), v_new], axis=1)
    qg = q.reshape(bsz, t, B_KV_HEADS, B_GROUP, HEAD_DIM)
    scores = jnp.einsum("bqgrd,bkgd->bgrqk", qg, k, preferred_element_type=jnp.float32) * SCALE
    p = sink_softmax(scores, sinks)
    out = jnp.einsum("bgrqk,bkgd->bqgrd", p.astype(v.dtype), v)
    return out.reshape(bsz, t, B_WIDTH)


def conv_ffn(h, conv_state, w_gate_up, conv_w, conv_b, w_down):
    t = h.shape[1]
    gate, up = jnp.split(jnp.einsum("bsd,df->bsf", h, w_gate_up), 2, axis=-1)
    ext = jnp.concatenate([conv_state.astype(gate.dtype), gate], axis=1)
    conv = conv_b
    for i in range(CONV_W):
        conv = conv + conv_w[i] * ext[:, i:i + t]
    y = jax.nn.silu(conv) * up
    return jnp.einsum("bsf,fd->bsd", y, w_down), ext[:, -(CONV_W - 1):]


def setup_inputs(seed: int = 0) -> dict:
    key = jax.random.key(seed)
    ks = jax.random.split(key, 21)

    def nrm(k, shape, scale=1.0):
        return scale * jax.random.normal(k, shape, jnp.float32)

    a_len = min(A_CTX, PAST_LEN)
    b_len = min(B_CTX, PAST_LEN)
    return {
        "x_prompt": nrm(ks[0], (BATCH, SEQ, D_MODEL)),
        "x_sample": nrm(ks[1], (DEC_BATCH, DEC_SEQ, D_MODEL)),
        "cache_a_k": nrm(ks[2], (DEPTH, DEC_BATCH, a_len, A_HEADS, HEAD_DIM)),
        "cache_a_v": nrm(ks[3], (DEPTH, DEC_BATCH, a_len, A_HEADS, HEAD_DIM)),
        "cache_b_k": nrm(ks[4], (DEPTH, DEC_BATCH, b_len, B_KV_HEADS, HEAD_DIM)),
        "cache_b_v": nrm(ks[5], (DEPTH, DEC_BATCH, b_len, B_KV_HEADS, HEAD_DIM)),
        "state_conv": nrm(ks[6], (DEPTH, DEC_BATCH, CONV_W - 1, D_FF)),
        "norm_attn": 1.0 + nrm(ks[7], (DEPTH, D_MODEL), 0.05),
        "w_in": nrm(ks[8], (DEPTH, D_MODEL, IN_COLS), D_MODEL ** -0.5),
        "q_norm_a": 1.0 + nrm(ks[9], (DEPTH, HEAD_DIM), 0.05),
        "k_norm_a": 1.0 + nrm(ks[10], (DEPTH, HEAD_DIM), 0.05),
        "rel_bias_a": nrm(ks[11], (DEPTH, A_HEADS, 2 * MAX_REL + 1), 0.1),
        "q_norm_b": 1.0 + nrm(ks[12], (DEPTH, HEAD_DIM), 0.05),
        "k_norm_b": 1.0 + nrm(ks[13], (DEPTH, HEAD_DIM), 0.05),
        "sinks_b": nrm(ks[14], (DEPTH, B_HEADS), 0.5),
        "w_out": nrm(ks[15], (DEPTH, MIX_WIDTH, D_MODEL), MIX_WIDTH ** -0.5),
        "norm_ffn": 1.0 + nrm(ks[16], (DEPTH, D_MODEL), 0.05),
        "w_gate_up": nrm(ks[17], (DEPTH, D_MODEL, 2 * D_FF), D_MODEL ** -0.5),
        "conv_w": nrm(ks[18], (DEPTH, CONV_W, D_FF), CONV_W ** -0.5),
        "conv_b": nrm(ks[19], (DEPTH, D_FF), 0.01),
        "w_down": nrm(ks[20], (DEPTH, D_FF, D_MODEL), D_FF ** -0.5),
    }


def reference(x_prompt, x_sample, cache_a_k, cache_a_v, cache_b_k, cache_b_v, state_conv,
              norm_attn, w_in, q_norm_a, k_norm_a, rel_bias_a, q_norm_b, k_norm_b, sinks_b,
              w_out, norm_ffn, w_gate_up, conv_w, conv_b, w_down):
    y_prompt = x_prompt
    y_sample = x_sample
    pos_p = jnp.arange(x_prompt.shape[1])
    pos_s = PAST_LEN + jnp.arange(x_sample.shape[1])
    zero_conv = jnp.zeros((x_prompt.shape[0], CONV_W - 1, D_FF), x_prompt.dtype)
    akp, avp, bkp, bvp, cvp = [], [], [], [], []
    aks, avs, bks, bvs, cvs = [], [], [], [], []
    for l in range(DEPTH):
        h = rms_norm(y_prompt, norm_attn[l])
        qa, ka, va, qb, kb, vb = project_heads(h, pos_p, w_in[l], q_norm_a[l], k_norm_a[l], q_norm_b[l], k_norm_b[l])
        oa = band_attn_a_prompt(qa, ka, va, rel_bias_a[l])
        ob = window_attn_b_prompt(qb, kb, vb, sinks_b[l])
        y_prompt = y_prompt + jnp.einsum("bsc,cd->bsd", jnp.concatenate([oa, ob], axis=-1), w_out[l])
        f, conv_new = conv_ffn(rms_norm(y_prompt, norm_ffn[l]), zero_conv, w_gate_up[l], conv_w[l], conv_b[l], w_down[l])
        y_prompt = y_prompt + f
        akp.append(ka[:, -A_CTX:])
        avp.append(va[:, -A_CTX:])
        bkp.append(kb[:, -B_CTX:])
        bvp.append(vb[:, -B_CTX:])
        cvp.append(conv_new)
        h = rms_norm(y_sample, norm_attn[l])
        qa, ka, va, qb, kb, vb = project_heads(h, pos_s, w_in[l], q_norm_a[l], k_norm_a[l], q_norm_b[l], k_norm_b[l])
        oa = band_attn_a_sample(qa, ka, va, cache_a_k[l], cache_a_v[l], rel_bias_a[l])
        ob = window_attn_b_sample(qb, kb, vb, cache_b_k[l], cache_b_v[l], sinks_b[l])
        y_sample = y_sample + jnp.einsum("bsc,cd->bsd", jnp.concatenate([oa, ob], axis=-1), w_out[l])
        f, conv_new = conv_ffn(rms_norm(y_sample, norm_ffn[l]), state_conv[l], w_gate_up[l], conv_w[l], conv_b[l], w_down[l])
        y_sample = y_sample + f
        aks.append(ka)
        avs.append(va)
        bks.append(kb)
        bvs.append(vb)
        cvs.append(conv_new)
    return (y_prompt, y_sample,
            jnp.stack(akp), jnp.stack(avp), jnp.stack(bkp), jnp.stack(bvp), jnp.stack(cvp),
            jnp.stack(aks), jnp.stack(avs), jnp.stack(bks), jnp.stack(bvs), jnp.stack(cvs))
```

```cpp
#include <hip/hip_runtime.h>
#include <hip/hip_cooperative_groups.h>
#include <cstdio>
#include <cstdint>
namespace cg = cooperative_groups;

#ifndef N_LAUNCH_MODE
#define N_LAUNCH_MODE 1
#endif

#ifndef REP
#define REP 0
#endif
#define NREP(k) ((((REP) >> (k)) & 1) + 1)
#ifndef PROBE_EPI
#define PROBE_EPI 1
#endif
#define LAS __attribute__((address_space(3)))
#define DI __device__ __forceinline__
typedef unsigned short bf16_t;
typedef short bf16x8 __attribute__((ext_vector_type(8)));
typedef short s16x4 __attribute__((ext_vector_type(4)));
typedef float f32x4 __attribute__((ext_vector_type(4)));
typedef float f32x16 __attribute__((ext_vector_type(16)));
typedef unsigned u32x4 __attribute__((ext_vector_type(4)));
typedef unsigned u32x2 __attribute__((ext_vector_type(2)));

constexpr int DM = 1024, SEQ = 16384, NSTREAM = 32, DSEQ = 64, MTOK = SEQ + NSTREAM * DSEQ;
constexpr int NIN = 2304, DFF = 2816, NGU = 2 * DFF;
constexpr int KA_ROWS = SEQ + NSTREAM * 576;
constexpr int KB_ROWS = SEQ + NSTREAM * 192;
constexpr int X1B_PROMPT_ROWS = 16512;
constexpr int GU_PT = 65;
constexpr float EPS = 1e-6f, LOG2E = 1.4426950408889634f;
constexpr float QSCALE = 0.125f * LOG2E;
constexpr size_t OFF_AKP = 18874368, OFF_AVP = 19136512, OFF_BKP = 19398656, OFF_BVP = 19415040, OFF_CVP = 19431424;
constexpr size_t OFF_AKS = 19437056, OFF_AVS = 20485632, OFF_BKS = 21534208, OFF_BVS = 21796352, OFF_CVS = 22058496;
constexpr size_t MiB = 1u << 20;
constexpr size_t WS_CTL = 0, WS_GAINS = 4096, WS_BAR = 16384, WS_SUMSQ = 65536, CTL_ZERO_BYTES = 160 * 1024;
constexpr size_t WS_WIN = 1 * MiB, WS_WOUT = 6 * MiB, WS_WGU = 8 * MiB, WS_WDN = 19 * MiB;
constexpr size_t WS_X1B = 25 * MiB, WS_O = 62 * MiB, WS_VTA = 98 * MiB, WS_KB = 132 * MiB, WS_VTB = 138 * MiB;
constexpr size_t WS_XN = 144 * MiB, WS_QA = 180 * MiB, WS_QB = 198 * MiB, WS_KA = 216 * MiB;
constexpr size_t WS_ROPE = 250 * MiB;
constexpr size_t WS_Y = 144 * MiB;
constexpr int LDS_BYTES = 155648, RING_BYTES = 131072;

struct Args { const float* in[21]; float* out; unsigned char* ws; int ph_lo, ph_hi; };

DI unsigned pk2(float lo, float hi) {
    typedef float f2 __attribute__((ext_vector_type(2))); typedef __bf16 b2 __attribute__((ext_vector_type(2)));
    f2 v = {lo, hi}; b2 b = __builtin_convertvector(v, b2); return __builtin_bit_cast(unsigned, b);
}
DI size_t kf_off(int h, int nblk, int krow, int d) { return ((((size_t)h * nblk + (krow >> 5)) * 4 + (d >> 4)) * 64 + ((d >> 3) & 1) * 32 + (krow & 31)) * 8 + (d & 7); }
DI size_t vf_off(int h, int nblk, int krow, int d) { const int kk = krow & 31; return (((((size_t)h * nblk + (krow >> 5)) * 2 + (d >> 5)) * 2 + (kk >> 4)) * 64 + ((kk >> 2) & 1) * 32 + (d & 31)) * 8 + 4 * ((kk >> 3) & 1) + (kk & 3); }
DI u32x2 pk4(f32x4 v) { u32x2 r; r.x = pk2(v[0], v[1]); r.y = pk2(v[2], v[3]); return r; }

namespace pg8 {
constexpr int BM = 256, BK = 64, HALF = 128, HTB = HALF * BK * 2, NXCD = 8, WGM = 8;
DI int lds_byte(int r, int c) { const int st = (r >> 4) * 2 + (c >> 5), rr = r & 15, cc = c & 31, ob = rr * 64 + cc * 2; return st * 1024 + (ob ^ (((ob >> 9) & 1) << 5)); }
DI void stage_rc(int b, int& R, int& C) { const int st = b / 1024, sb = b % 1024, swz = sb ^ (((sb >> 9) & 1) << 5); R = (st >> 1) * 16 + swz / 64; C = (st & 1) * 32 + (swz % 64) / 2; }

struct Unit { int pm, pn, kt0, nkt; };
struct Gemm { const bf16_t* A; const bf16_t* Bt; int K; };

template <int GU> struct Order {
    int nM, nN, nwg, G, c, nkt;
    DI void init(int nM_, int nN_, int G_, int c_, int nkt_) { nM = nM_; nN = nN_; nwg = nM * nN; G = G_; c = c_; nkt = nkt_; }
    DI bool next(int i, Unit& u) const {
        const long L = (long)i * G + c; if (L >= nwg) return false;
        u.kt0 = 0; u.nkt = nkt;
        int wgid = (int)L; { const int q = nwg / NXCD, r = nwg % NXCD, xcd = wgid % NXCD, off = wgid / NXCD; wgid = (xcd < r ? xcd * (q + 1) : r * (q + 1) + (xcd - r) * q) + off; }
        const int nig = WGM * nN, gid = wgid / nig, fm = gid * WGM, gsz = (nM - fm) < WGM ? (nM - fm) : WGM;
        u.pm = fm + ((wgid % nig) % gsz); u.pn = (wgid % nig) / gsz; return true;
    }
    DI size_t a_row(int pm) const { return GU ? (size_t)(pm < GU_PT ? 254 * pm : X1B_PROMPT_ROWS + 256 * (pm - GU_PT)) : (size_t)pm * 256; }
};

template <int KIND> struct RangeOrder {
    int s, stride, cnt;
    DI bool next(int i, Unit& u) const {
        if (i >= cnt) return false;
        const int idx = s + i * stride;
        if (KIND == 4) { const int g = idx / 176, w = idx - 176 * g, gsz = (73 - 8 * g) < 8 ? (73 - 8 * g) : 8;
            u.pm = 8 * g + w % gsz; u.pn = w / gsz; u.kt0 = 0; u.nkt = 16; }
        else { u.pm = idx >> 2; u.pn = idx & 3; u.kt0 = 0; u.nkt = KIND == 5 ? 44 : 16; }
        return true;
    }
    DI size_t a_row(int pm) const { return KIND == 4 ? (size_t)(pm < GU_PT ? 254 * pm : X1B_PROMPT_ROWS + 256 * (pm - GU_PT)) : (size_t)pm * 256; }
};
struct OrderSK {
    static constexpr int NP = 22, NU = 288;
    int s, e;
    DI void init(int G, int c) { const int v = (G % 8 == 0) ? (c % 8) * (G / 8) + c / 8 : c; s = (int)((long)v * (NU * NP) / G); e = (int)((long)(v + 1) * (NU * NP) / G); }
    DI bool next(int i, Unit& u) const {
        int p = s;
        for (int k = 0; k < i; ++k) p = (p / NP + 1) * NP;
        if (p >= e) return false;
        const int unit = p / NP, pe = (unit + 1) * NP < e ? (unit + 1) * NP : e;
        u.kt0 = (p - unit * NP) * 2; u.nkt = (pe - p) * 2;
        u.pm = (unit >> 5) * 8 + (unit & 7); u.pn = (unit & 31) >> 3; return true;
    }
    DI size_t a_row(int pm) const { return (size_t)pm * 256; }
};

template <class Epi, class Sched, bool ALIGN_EPI>
DI void gemm_phase(LAS unsigned char* lds, const Gemm g, const Sched& S, const Epi& E) {
    const int tid = threadIdx.x, wid = __builtin_amdgcn_readfirstlane(tid >> 6), lane = tid & 63, wr = wid >> 2, wc = wid & 3, fr = lane & 15, fq = lane >> 4;
    const int K = g.K;
    unsigned voffA[2];
#pragma unroll
    for (int i = 0; i < 2; ++i) { int R, C; stage_rc(tid * 16 + i * 8192, R, C); voffA[i] = (unsigned)(R * K + C) * 2u; }
    const size_t kstep = (size_t)(BK * 2);
    const size_t hstep = (size_t)HALF * K * 2;
    const size_t rowb = (size_t)K * 2;
    const unsigned ldsw = (unsigned)wid * 1024u;
    const int aoff = lds_byte(wr * 64 + fr, fq * 8), boff = lds_byte(wc * 32 + fr, fq * 8);
#define PG8_SA(b, h) (((b) * 2 + (h)) * HTB)
#define PG8_SB(b, h) ((4 + (b) * 2 + (h)) * HTB)
#define PG8_STAGE(bufoff, gbase, voff) do { _Pragma("unroll") for (int _i = 0; _i < 2; ++_i) \
        __builtin_amdgcn_global_load_lds((const unsigned*)((const char*)(gbase) + (voff)[_i]), (LAS unsigned*)(lds + (bufoff) + ldsw + _i * 8192), 16, 0, 0); } while (0)
#define PG8_LDA(dst, b, h) do { _Pragma("unroll") for (int m = 0; m < 4; ++m) _Pragma("unroll") for (int k = 0; k < 2; ++k) dst[m][k] = *(const LAS bf16x8*)(lds + PG8_SA(b, h) + aoff + m * 2048 + k * 1024); } while (0)
#define PG8_LDB(dst, b, h) do { _Pragma("unroll") for (int n = 0; n < 2; ++n) _Pragma("unroll") for (int k = 0; k < 2; ++k) dst[n][k] = *(const LAS bf16x8*)(lds + PG8_SB(b, h) + boff + n * 2048 + k * 1024); } while (0)
#define PG8_MMA(ai, bj, At, Bt) do { __builtin_amdgcn_s_setprio(1); _Pragma("unroll") for (int m = 0; m < 4; ++m) _Pragma("unroll") for (int n = 0; n < 2; ++n) _Pragma("unroll") for (int k = 0; k < 2; ++k) \
        acc[ai][bj][m][n] = __builtin_amdgcn_mfma_f32_16x16x32_bf16(Bt[n][k], At[m][k], acc[ai][bj][m][n], 0, 0, 0); __builtin_amdgcn_s_setprio(0); } while (0)
#define PG8_WAIT_V(n) asm volatile("s_waitcnt vmcnt(" #n ")" ::: "memory")
#define PG8_WAIT_L(n) asm volatile("s_waitcnt lgkmcnt(" #n ")" ::: "memory")
#define PG8_BAR __builtin_amdgcn_s_barrier()
#define PG8_SCHED __builtin_amdgcn_sched_barrier(0)
    Unit cur, nxt; int ui = 0;
    if (!S.next(0, cur)) return;
    f32x4 acc[2][2][4][2];
#pragma unroll
    for (int a = 0; a < 2; ++a)
#pragma unroll
        for (int b = 0; b < 2; ++b)
#pragma unroll
            for (int m = 0; m < 4; ++m)
#pragma unroll
                for (int n = 0; n < 2; ++n) acc[a][b][m][n] = (f32x4){0.f, 0.f, 0.f, 0.f};
    bf16x8 At[4][2], B0[2][2], B1[2][2];
    const char* cA = (const char*)g.A + S.a_row(cur.pm) * rowb + (size_t)cur.kt0 * kstep; const char* cB = (const char*)g.Bt + (size_t)cur.pn * 2 * hstep + (size_t)cur.kt0 * kstep;
    PG8_STAGE(PG8_SB(0, 0), cB, voffA); PG8_STAGE(PG8_SB(0, 1), cB + hstep, voffA); PG8_STAGE(PG8_SA(0, 0), cA, voffA); PG8_STAGE(PG8_SA(0, 1), cA + hstep, voffA);
    if (wr == 1) PG8_BAR;
    PG8_WAIT_V(2); PG8_BAR;
    PG8_STAGE(PG8_SB(1, 0), cB + kstep, voffA); PG8_STAGE(PG8_SA(1, 0), cA + kstep, voffA); PG8_STAGE(PG8_SB(1, 1), cB + hstep + kstep, voffA);
    PG8_WAIT_V(6); PG8_BAR;
    for (;;) {
        const bool has_next = S.next(ui + 1, nxt);
        const char* nA = has_next ? (const char*)g.A + S.a_row(nxt.pm) * rowb + (size_t)nxt.kt0 * kstep : cA; const char* nB = has_next ? (const char*)g.Bt + (size_t)nxt.pn * 2 * hstep + (size_t)nxt.kt0 * kstep : cB;
        const int nt = cur.nkt;
        for (int t = 0; t < nt; t += 2) {
            const bool last = (t == nt - 2);
            const char* a1 = cA + (size_t)(t + 1) * kstep;
            const char* a2 = last ? nA : cA + (size_t)(t + 2) * kstep; const char* b2 = last ? nB : cB + (size_t)(t + 2) * kstep;
            const char* a3 = a2 + kstep; const char* b3 = b2 + kstep;
            PG8_LDB(B0, 0, 0); PG8_LDB(B1, 0, 1); PG8_SCHED; PG8_LDA(At, 0, 0); PG8_STAGE(PG8_SA(1, 1), a1 + hstep, voffA);
            PG8_WAIT_V(8); PG8_WAIT_L(0); PG8_BAR; PG8_MMA(0, 0, At, B0); PG8_MMA(0, 1, At, B1); PG8_BAR; PG8_SCHED;
            PG8_LDA(At, 0, 1); PG8_STAGE(PG8_SB(0, 0), b2, voffA); PG8_STAGE(PG8_SB(0, 1), b2 + hstep, voffA); PG8_STAGE(PG8_SA(0, 0), a2, voffA);
            PG8_WAIT_V(8); PG8_WAIT_L(0); PG8_BAR; PG8_MMA(1, 0, At, B0); PG8_MMA(1, 1, At, B1); PG8_BAR; PG8_SCHED;
            PG8_LDB(B0, 1, 0); PG8_LDB(B1, 1, 1); PG8_SCHED; PG8_LDA(At, 1, 0); PG8_STAGE(PG8_SA(0, 1), a2 + hstep, voffA);
            PG8_WAIT_V(8); PG8_WAIT_L(0); PG8_BAR; PG8_MMA(0, 0, At, B0); PG8_MMA(0, 1, At, B1); PG8_BAR; PG8_SCHED;
            PG8_LDA(At, 1, 1); PG8_STAGE(PG8_SB(1, 0), b3, voffA); PG8_STAGE(PG8_SB(1, 1), b3 + hstep, voffA); PG8_STAGE(PG8_SA(1, 0), a3, voffA);
            PG8_WAIT_V(8); PG8_WAIT_L(0); PG8_BAR; PG8_MMA(1, 0, At, B0); PG8_MMA(1, 1, At, B1); PG8_BAR; PG8_SCHED;
        }
        if constexpr (ALIGN_EPI) { if (wr == 0) PG8_BAR; }
        E(acc, cur, wr, wc, fr, fq, lds + RING_BYTES);
        if constexpr (NREP(7) == 2 && Epi::PROBE2) E(acc, cur, wr, wc, fr, fq, lds + RING_BYTES);
        if (!has_next) break;
#pragma unroll
        for (int a = 0; a < 2; ++a)
#pragma unroll
            for (int b = 0; b < 2; ++b)
#pragma unroll
                for (int m = 0; m < 4; ++m)
#pragma unroll
                    for (int n = 0; n < 2; ++n) acc[a][b][m][n] = (f32x4){0.f, 0.f, 0.f, 0.f};
        cur = nxt; cA = nA; cB = nB; ++ui;
        if constexpr (ALIGN_EPI) { if (wr == 1) PG8_BAR; }
    }
    PG8_WAIT_V(0);
    if constexpr (!ALIGN_EPI) { if (wr == 0) PG8_BAR; }
    PG8_BAR;
#undef PG8_SA
#undef PG8_SB
#undef PG8_STAGE
#undef PG8_LDA
#undef PG8_LDB
#undef PG8_MMA
#undef PG8_WAIT_V
#undef PG8_WAIT_L
#undef PG8_BAR
#undef PG8_SCHED
}
}
using pg8::Unit;
typedef f32x4 AccT[2][2][4][2];

struct EpiQKV {
    static constexpr bool PROBE2 = (PROBE_EPI == 1);
    const float* gains;
    unsigned char* ws; float* out;
    DI void operator()(const AccT& acc, const Unit& u, int wr, int wc, int fr, int fq, LAS unsigned char*) const {
        const int hh = u.pn * 4 + wc;
        int kind, h;
        if (hh < 8) { kind = 0; h = hh; } else if (hh < 16) { kind = 1; h = hh - 8; } else if (hh < 24) { kind = 2; h = hh - 16; }
        else if (hh < 32) { kind = 3; h = hh - 24; } else if (hh < 34) { kind = 4; h = hh - 32; } else { kind = 5; h = hh - 34; }
        const bool donorm = (kind != 2 && kind != 5), dorope = (kind == 3 || kind == 4);
        const float* gain = gains + 64 * (kind == 0 ? 0 : (kind == 1 ? 1 : (kind == 3 ? 2 : 3)));
        f32x4 gv[2][2];
#pragma unroll
        for (int bj = 0; bj < 2; ++bj)
#pragma unroll
            for (int n = 0; n < 2; ++n) gv[bj][n] = donorm ? *(const f32x4*)(gain + 32 * bj + 16 * n + 4 * fq) : (f32x4){1.f, 1.f, 1.f, 1.f};
#pragma unroll
        for (int ai = 0; ai < 2; ++ai)
#pragma unroll
            for (int m = 0; m < 4; ++m) {
                const int row = u.pm * 256 + ai * 128 + wr * 64 + m * 16 + fr;
                f32x4 v[2][2];
#pragma unroll
                for (int bj = 0; bj < 2; ++bj)
#pragma unroll
                    for (int n = 0; n < 2; ++n) v[bj][n] = acc[ai][bj][m][n];
                if (donorm) {
                    float ss = 0.f;
#pragma unroll
                    for (int bj = 0; bj < 2; ++bj)
#pragma unroll
                        for (int n = 0; n < 2; ++n) ss += (v[bj][n][0] * v[bj][n][0] + v[bj][n][1] * v[bj][n][1]) + (v[bj][n][2] * v[bj][n][2] + v[bj][n][3] * v[bj][n][3]);
                    ss += __shfl_xor(ss, 16); ss += __shfl_xor(ss, 32);
                    const float rs = rsqrtf(ss * (1.f / 64.f) + EPS);
#pragma unroll
                    for (int bj = 0; bj < 2; ++bj)
#pragma unroll
                        for (int n = 0; n < 2; ++n) v[bj][n] = v[bj][n] * rs * gv[bj][n];
                }
                if (dorope) {
                    const int pos = row < SEQ ? row : 1024 + ((row - SEQ) & 63);
                    const f32x4* rt = (const f32x4*)((const float*)(ws + WS_ROPE) + ((size_t)pos * 32 + 4 * fq) * 2);
#pragma unroll
                    for (int n = 0; n < 2; ++n) {
                        const f32x4 t0 = rt[8 * n], t1 = rt[8 * n + 1];
                        const float cs[4] = {t0[0], t0[2], t1[0], t1[2]}, sn[4] = {t0[1], t0[3], t1[1], t1[3]};
#pragma unroll
                        for (int j = 0; j < 4; ++j) { const float x1 = v[0][n][j], x2 = v[1][n][j]; v[0][n][j] = x1 * cs[j] - x2 * sn[j]; v[1][n][j] = x2 * cs[j] + x1 * sn[j]; }
                    }
                }
                if (kind == 0 || kind == 3) {
                    bf16_t* q = (bf16_t*)(ws + (kind == 0 ? WS_QA : WS_QB)) + ((size_t)h * MTOK + row) * 64 + 4 * fq;
#pragma unroll
                    for (int bj = 0; bj < 2; ++bj)
#pragma unroll
                        for (int n = 0; n < 2; ++n) *(u32x2*)(q + 32 * bj + 16 * n) = pk4(v[bj][n] * QSCALE);
                } else {
                    const bool isA = (kind == 1 || kind == 2), isK = (kind == 1 || kind == 4);
                    const int srow = row - SEQ;
                    const int band = isA ? 576 : 192, past = isA ? 512 : 128, nh = isA ? 8 : 2;
                    const int krow = row < SEQ ? row : SEQ + (srow >> 6) * band + past + (srow & 63);
                    const int krows = isA ? KA_ROWS : KB_ROWS;
                    float* op = nullptr;
                    size_t ooff = 0; bool has_o = false;
                    if (row >= SEQ) { ooff = (isA ? (isK ? OFF_AKS : OFF_AVS) : (isK ? OFF_BKS : OFF_BVS)) + ((size_t)srow * nh + h) * 64; has_o = true; }
                    else if (row >= SEQ - past) { ooff = (isA ? (isK ? OFF_AKP : OFF_AVP) : (isK ? OFF_BKP : OFF_BVP)) + ((size_t)(row - (SEQ - past)) * nh + h) * 64; has_o = true; }
                    op = out + ooff;
                    if (has_o) {
#pragma unroll
                        for (int bj = 0; bj < 2; ++bj)
#pragma unroll
                            for (int n = 0; n < 2; ++n) *(f32x4*)(op + 32 * bj + 16 * n + 4 * fq) = v[bj][n];
                    }
                    if (isK) {
                        bf16_t* kp = (bf16_t*)(ws + (isA ? WS_KA : WS_KB));
#pragma unroll
                        for (int bj = 0; bj < 2; ++bj)
#pragma unroll
                            for (int n = 0; n < 2; ++n) *(u32x2*)(kp + kf_off(h, krows >> 5, krow, 32 * bj + 16 * n + 4 * fq)) = pk4(v[bj][n]);
                    } else {
                        bf16_t* vp = (bf16_t*)(ws + (isA ? WS_VTA : WS_VTB));
#pragma unroll
                        for (int bj = 0; bj < 2; ++bj)
#pragma unroll
                            for (int n = 0; n < 2; ++n)
#pragma unroll
                                for (int j = 0; j < 4; ++j) {
                                    const float mine = v[bj][n][j], oth = __shfl_xor(mine, 1);
                                    if (!(fr & 1)) *(unsigned*)(vp + vf_off(h, krows >> 5, krow, 32 * bj + 16 * n + 4 * fq + j)) = pk2(mine, oth);
                                }
                    }
                }
            }
    }
};

struct EpiNull {
    static constexpr bool PROBE2 = false;
    DI void operator()(const AccT& acc, const Unit& u, int wr, int wc, int fr, int fq, LAS unsigned char*) const {
#pragma unroll
        for (int ai = 0; ai < 2; ++ai)
#pragma unroll
            for (int bj = 0; bj < 2; ++bj)
#pragma unroll
                for (int m = 0; m < 4; ++m)
#pragma unroll
                    for (int n = 0; n < 2; ++n) asm volatile("" :: "v"(acc[ai][bj][m][n]));
    }
};
struct EpiOut {
    static constexpr bool PROBE2 = false;
    const float *xp, *xs; float* out; bf16_t* X1B; float* sumsq;
    DI void operator()(const AccT& acc, const Unit& u, int wr, int wc, int fr, int fq, LAS unsigned char*) const {
        const int col0 = u.pn * 256 + wc * 32 + 4 * fq;
#pragma unroll
        for (int ai = 0; ai < 2; ++ai)
#pragma unroll
            for (int m = 0; m < 4; ++m) {
                const int row = u.pm * 256 + ai * 128 + wr * 64 + m * 16 + fr;
                const float* xr = (row < SEQ ? xp + (size_t)row * DM : xs + (size_t)(row - SEQ) * DM) + col0;
                bf16_t* brow = X1B + (size_t)(row < SEQ ? row + 2 : row + (X1B_PROMPT_ROWS - SEQ)) * DM + col0;
                float ss = 0.f;
#pragma unroll
                for (int bj = 0; bj < 2; ++bj)
#pragma unroll
                    for (int n = 0; n < 2; ++n) {
                        const int c = bj * 128 + n * 16;
                        const f32x4 o = *(const f32x4*)(xr + c) + acc[ai][bj][m][n];
                        *(u32x2*)(brow + c) = pk4(o);
                        ss += (o[0] * o[0] + o[1] * o[1]) + (o[2] * o[2] + o[3] * o[3]);
                    }
                ss += __shfl_xor(ss, 16); ss += __shfl_xor(ss, 32);
                if (fq == 0) unsafeAtomicAdd(sumsq + row, ss);
            }
    }
};

struct EpiGU {
    static constexpr bool PROBE2 = (PROBE_EPI == 4);
    const float *sumsq, *convw, *convb, *state; bf16_t* Y; float* out;
    DI void operator()(const AccT& acc, const Unit& u, int wr, int wc, int fr, int fq, LAS unsigned char* ldsx) const {
        LAS float* H = (LAS float*)ldsx;
        const int T = u.pm; const bool prompt = T < GU_PT; const int lane = fq * 16 + fr;
        const int tok0 = (prompt ? 254 * T - 2 : SEQ + 256 * (T - GU_PT)) + 64 * wr + fr;
        float rs[2][4];
#pragma unroll
        for (int ai = 0; ai < 2; ++ai)
#pragma unroll
            for (int m = 0; m < 4; ++m) { const int tok = tok0 + 128 * ai + 16 * m; const bool ok = tok >= 0 && tok < (prompt ? SEQ : MTOK);
                rs[ai][m] = ok ? rsqrtf(sumsq[ok ? tok : 0] * (1.f / DM) + EPS) : 0.f; }
        if (prompt) {
            if (fr >= 14) {
#pragma unroll
                for (int ai = 0; ai < 2; ++ai)
#pragma unroll
                    for (int n = 0; n < 2; ++n) *(LAS f32x4*)(H + ((ai * 2 + wr) * 4 + wc) * 64 + (fr - 14) * 32 + 16 * n + 4 * fq) = acc[ai][0][3][n] * rs[ai][3];
            }
            asm volatile("s_waitcnt lgkmcnt(0)" ::: "memory"); __builtin_amdgcn_s_barrier(); asm volatile("" ::: "memory");
        }
#pragma unroll
        for (int n = 0; n < 2; ++n) {
            const int f = u.pn * 128 + wc * 32 + 16 * n + 4 * fq;
            const f32x4 w0 = *(const f32x4*)(convw + f), w1 = *(const f32x4*)(convw + DFF + f), w2 = *(const f32x4*)(convw + 2 * DFF + f), cb = *(const f32x4*)(convb + f);
#pragma unroll
            for (int ai = 0; ai < 2; ++ai) {
                f32x4 hm1 = {0.f, 0.f, 0.f, 0.f}, hm2 = {0.f, 0.f, 0.f, 0.f};
                const int sb = 4 * (T - GU_PT) + 2 * ai + wr;
                if (prompt) {
                    if (ai | wr) { const int sai = wr ? ai : ai - 1, swr = wr ^ 1; const LAS float* hp = H + ((sai * 2 + swr) * 4 + wc) * 64 + 16 * n + 4 * fq;
                        hm2 = *(const LAS f32x4*)hp; hm1 = *(const LAS f32x4*)(hp + 32); }
                } else { hm2 = *(const f32x4*)(state + (size_t)(sb * 2) * DFF + f); hm1 = *(const f32x4*)(state + (size_t)(sb * 2 + 1) * DFF + f); }
                f32x4 p1 = hm1, p2;
#pragma unroll
                for (int j = 0; j < 4; ++j) p2[j] = fr == 1 ? hm1[j] : hm2[j];
#pragma unroll
                for (int m = 0; m < 4; ++m) {
                    const f32x4 g = acc[ai][0][m][n] * rs[ai][m];
                    f32x4 gm1, gm2;
#pragma unroll
                    for (int j = 0; j < 4; ++j) {
                        gm1[j] = __int_as_float(__builtin_amdgcn_update_dpp(__float_as_int(p1[j]), __float_as_int(g[j]), 0x111, 0xf, 0xf, false));
                        gm2[j] = __int_as_float(__builtin_amdgcn_update_dpp(__float_as_int(p2[j]), __float_as_int(g[j]), 0x112, 0xf, 0xf, false));
                        if (m < 3) {
                            p1[j] = __int_as_float(__builtin_amdgcn_update_dpp(0, __float_as_int(g[j]), 0x121, 0xf, 0xf, false));
                            p2[j] = __int_as_float(__builtin_amdgcn_update_dpp(0, __float_as_int(g[j]), 0x122, 0xf, 0xf, false)); }
                    }
                    const f32x4 cv = cb + w0 * gm2 + w1 * gm1 + w2 * g;
                    const f32x4 up = acc[ai][1][m][n] * rs[ai][m];
                    f32x4 y;
#pragma unroll
                    for (int j = 0; j < 4; ++j) y[j] = cv[j] * __builtin_amdgcn_rcpf(1.f + __builtin_amdgcn_exp2f(-cv[j] * LOG2E)) * up[j];
                    const int tok = tok0 + 128 * ai + 16 * m;
                    const int rloc = 128 * ai + 64 * wr + 16 * m + fr;
                    const bool ok = prompt ? (rloc >= 2 && tok < SEQ) : true;
                    if (ok) *(u32x2*)(Y + (size_t)tok * DFF + f) = pk4(y);
                    if (prompt) { if (tok == SEQ - 2 || tok == SEQ - 1) *(f32x4*)(out + OFF_CVP + (size_t)(tok - (SEQ - 2)) * DFF + f) = g; }
                    else if (m == 3 && fr >= 14) *(f32x4*)(out + OFF_CVS + (size_t)(sb * 2 + (fr - 14)) * DFF + f) = g;
                }
            }
        }
    }
};

struct EpiDown {
    static constexpr bool PROBE2 = false;
    float* out; const bf16_t* X1B;
    DI void operator()(const AccT& acc, const Unit& u, int wr, int wc, int fr, int fq, LAS unsigned char*) const {
        const int col0 = u.pn * 256 + wc * 32 + 4 * fq;
#pragma unroll
        for (int ai = 0; ai < 2; ++ai)
#pragma unroll
            for (int m = 0; m < 4; ++m) {
                const int row = u.pm * 256 + ai * 128 + wr * 64 + m * 16 + fr;
                float* orow = out + (size_t)row * DM + col0;
                const bf16_t* brow = X1B + (size_t)(row < SEQ ? row + 2 : row + (X1B_PROMPT_ROWS - SEQ)) * DM + col0;
#pragma unroll
                for (int bj = 0; bj < 2; ++bj)
#pragma unroll
                    for (int n = 0; n < 2; ++n) { const int c = bj * 128 + n * 16; const u32x2 xb = *(const u32x2*)(brow + c);
                        const f32x4 xr = {__uint_as_float(xb.x << 16), __uint_as_float(xb.x & 0xffff0000u), __uint_as_float(xb.y << 16), __uint_as_float(xb.y & 0xffff0000u)};
                        *(f32x4*)(orow + c) = xr + acc[ai][bj][m][n]; }
            }
    }
};

#define MFMA32(a, b, c) __builtin_amdgcn_mfma_f32_32x32x16_bf16((a), (b), (c), 0, 0, 0)
DI void kv_dma(const bf16_t* Kg, const bf16_t* Vg, int blk, LAS unsigned char* slot) {
#pragma unroll
    for (int f = 0; f < 4; ++f) __builtin_amdgcn_global_load_lds((const unsigned*)(Kg + (size_t)blk * 2048 + f * 512), (LAS unsigned*)(slot + f * 1024), 16, 0, 0);
#pragma unroll
    for (int f = 0; f < 4; ++f) __builtin_amdgcn_global_load_lds((const unsigned*)(Vg + (size_t)blk * 2048 + f * 512), (LAS unsigned*)(slot + 4096 + f * 1024), 16, 0, 0);
}
template <bool ISB>
DI void attn_block(const LAS unsigned char* slot, const bf16x8 (&qf)[2][4], f32x16 (&o)[2][2], float (&mrun)[2], float (&lrun)[2], int kb, int r, int hh, int lane, const LAS float* biasR, float bconst, int qoff, int nq) {
    bf16x8 kf[4], vf[2][2];
#pragma unroll
    for (int ds = 0; ds < 4; ++ds) kf[ds] = *(const LAS bf16x8*)(slot + ds * 1024 + lane * 16);
#pragma unroll
    for (int db = 0; db < 2; ++db)
#pragma unroll
        for (int t = 0; t < 2; ++t) vf[db][t] = *(const LAS bf16x8*)(slot + 4096 + (db * 2 + t) * 1024 + lane * 16);
#pragma unroll
    for (int qb = 0; qb < 2; ++qb) {
        if (qb >= nq) continue;
        f32x16 s;
#pragma unroll
        for (int i = 0; i < 16; ++i) s[i] = 0.f;
#pragma unroll
        for (int ds = 0; ds < 4; ++ds) s = MFMA32(kf[ds], qf[qb][ds], s);
        float cadd = 0.f;
        if (!ISB) {
            if (kb >= 12) {
                const LAS float* bp = biasR + (191 - (512 + qoff + 32 * qb + r - 32 * kb - 4 * hh));
#pragma unroll
                for (int i = 0; i < 16; ++i) s[i] += bp[8 * (i >> 2) + (i & 3)];
            } else cadd = bconst;
        }
        float mx = fmaxf(fmaxf(s[0], s[1]), s[2]);
#pragma unroll
        for (int i = 3; i < 15; i += 2) mx = fmaxf(fmaxf(mx, s[i]), s[i + 1]);
        mx = fmaxf(mx, s[15]);
        mx = fmaxf(mx, __shfl_xor(mx, 32)) + cadd;
        if (__any(mx > mrun[qb] + 8.f)) {
            const float mnew = fmaxf(mrun[qb], mx), alpha = __builtin_amdgcn_exp2f(mrun[qb] - mnew);
            mrun[qb] = mnew; lrun[qb] *= alpha;
#pragma unroll
            for (int i = 0; i < 16; ++i) { o[qb][0][i] *= alpha; o[qb][1][i] *= alpha; }
        }
        const float c = cadd - mrun[qb];
        float psum = 0.f;
#pragma unroll
        for (int i = 0; i < 16; ++i) { s[i] = __builtin_amdgcn_exp2f(s[i] + c); psum += s[i]; }
        lrun[qb] += psum;
        bf16x8 pf[2];
#pragma unroll
        for (int t = 0; t < 2; ++t) { u32x4 p; p.x = pk2(s[8 * t], s[8 * t + 1]); p.y = pk2(s[8 * t + 2], s[8 * t + 3]); p.z = pk2(s[8 * t + 4], s[8 * t + 5]); p.w = pk2(s[8 * t + 6], s[8 * t + 7]);
            pf[t] = __builtin_bit_cast(bf16x8, p); }
#pragma unroll
        for (int db = 0; db < 2; ++db)
#pragma unroll
            for (int t = 0; t < 2; ++t) o[qb][db] = MFMA32(vf[db][t], pf[t], o[qb][db]);
    }
}
template <bool ISB>
DI void attn_unit(int u, int hq, int qoff, int nq, const bf16_t* Qb, const bf16_t* Kb, const bf16_t* Vtb, bf16_t* O, const float* sinks, const LAS float* biasL, LAS unsigned char* ring, int lane) {
    constexpr int NCH = ISB ? 3 : 9, KROWS = ISB ? KB_ROWS : KA_ROWS;
    const int r = lane & 31, hh = lane >> 5;
    const int hk = ISB ? (hq >> 2) : hq;
    int kbase, j0;
    if (u < 256) { kbase = 64 * (u - (NCH - 1)); j0 = (NCH - 1) - u; if (j0 < 0) j0 = 0; } else { kbase = SEQ + (u - 256) * (64 * NCH); j0 = 0; }
    const bf16_t* Qp = Qb + ((size_t)hq * MTOK + 64 * u + qoff) * 64;
    const bf16_t* Kp = Kb + (size_t)hk * KROWS * 64 + 8 * lane;
    const bf16_t* Vp = Vtb + (size_t)hk * KROWS * 64 + 8 * lane;
    const int kb0 = 2 * j0, kbN = 2 * NCH, blk0 = (kbase >> 5) + kb0, nb = kbN - kb0;
    asm volatile("s_waitcnt vmcnt(0) lgkmcnt(0)" ::: "memory");
    kv_dma(Kp, Vp, blk0, ring);
    kv_dma(Kp, Vp, blk0 + 1, ring + 8192);
    bf16x8 qf[2][4];
#pragma unroll
    for (int qb = 0; qb < 2; ++qb)
#pragma unroll
        for (int ds = 0; ds < 4; ++ds) qf[qb][ds] = *(const bf16x8*)(Qp + (qb < nq ? 32 * qb + r : r) * 64 + 16 * ds + 8 * hh);
    f32x16 o[2][2];
#pragma unroll
    for (int a = 0; a < 2; ++a)
#pragma unroll
        for (int b = 0; b < 2; ++b)
#pragma unroll
            for (int i = 0; i < 16; ++i) o[a][b][i] = 0.f;
    float mrun[2], lrun[2];
#pragma unroll
    for (int a = 0; a < 2; ++a) {
        if (ISB) { mrun[a] = sinks[hq] * LOG2E; lrun[a] = hh ? 0.f : 1.f; }
        else { mrun[a] = -1e30f; lrun[a] = 0.f; } }
    const LAS float* biasR = biasL + hq * 256;
    const float bconst = ISB ? 0.f : biasR[0];
    asm volatile("s_waitcnt vmcnt(0)" ::: "memory");
    for (int ib = 0; ib < nb; ++ib) {
        LAS unsigned char* slot = ring + (ib & 1) * 8192;
        if (ib >= 2) { if (ib + 1 < nb) asm volatile("s_waitcnt vmcnt(8)" ::: "memory"); else asm volatile("s_waitcnt vmcnt(0)" ::: "memory"); }
        attn_block<ISB>(slot, qf, o, mrun, lrun, kb0 + ib, r, hh, lane, biasR, bconst, qoff, nq);
        if (ib + 2 < nb) { asm volatile("s_waitcnt lgkmcnt(0)" ::: "memory"); __builtin_amdgcn_sched_barrier(0); kv_dma(Kp, Vp, blk0 + ib + 2, slot); }
    }
#pragma unroll
    for (int qb = 0; qb < 2; ++qb) {
        if (qb >= nq) continue;
        const float l = lrun[qb] + __shfl_xor(lrun[qb], 32), inv = 1.f / l;
        bf16_t* op = O + (size_t)(64 * u + qoff + 32 * qb + r) * DM + (ISB ? 512 : 0) + hq * 64 + 4 * hh;
#pragma unroll
        for (int db = 0; db < 2; ++db)
#pragma unroll
            for (int i4 = 0; i4 < 4; ++i4) { f32x4 v = {o[qb][db][4 * i4] * inv, o[qb][db][4 * i4 + 1] * inv, o[qb][db][4 * i4 + 2] * inv, o[qb][db][4 * i4 + 3] * inv};
                *(u32x2*)(op + 32 * db + 8 * i4) = pk4(v); }
    }
}

DI float wave_sum(float v) {
#pragma unroll
    for (int o = 1; o < 64; o <<= 1) v += __shfl_xor(v, o);
    return v;
}
DI void transpose_item(const float* W, int ldw, int k0, int n, bf16_t* WT, int Kd, int dst_row, const float* kscale) {
    float v[64];
#pragma unroll
    for (int i = 0; i < 64; ++i) v[i] = W[(size_t)(k0 + i) * ldw + n];
    if (kscale) {
#pragma unroll
        for (int i = 0; i < 64; ++i) v[i] *= kscale[k0 + i];
    }
    bf16_t* d = WT + (size_t)dst_row * Kd + k0;
#pragma unroll
    for (int c = 0; c < 8; ++c) { u32x4 o; o.x = pk2(v[8 * c], v[8 * c + 1]); o.y = pk2(v[8 * c + 2], v[8 * c + 3]); o.z = pk2(v[8 * c + 4], v[8 * c + 5]); o.w = pk2(v[8 * c + 6], v[8 * c + 7]);
        *(u32x4*)(d + 8 * c) = o; }
}
DI void vt_item(const float* src, int past, int nh, int band, int krows, bf16_t* VT, int item, int lane) {
    const int nrb = past / 32, rb = item % nrb, h = (item / nrb) % nh, b = item / (nrb * nh), r0 = rb * 32;
    float v[32];
#pragma unroll
    for (int i = 0; i < 32; ++i) v[i] = src[(((size_t)b * past + r0 + i) * nh + h) * 64 + lane];
    const int krow = SEQ + b * band + r0;
#pragma unroll
    for (int t = 0; t < 2; ++t)
#pragma unroll
        for (int hh = 0; hh < 2; ++hh) { const int k0 = 16 * t + 4 * hh; u32x4 o; o.x = pk2(v[k0], v[k0 + 1]); o.y = pk2(v[k0 + 2], v[k0 + 3]); o.z = pk2(v[k0 + 8], v[k0 + 9]); o.w = pk2(v[k0 + 10], v[k0 + 11]);
            *(u32x4*)(VT + vf_off(h, krows >> 5, krow + k0, lane)) = o; }
}

typedef const __attribute__((address_space(4))) Args* KArgs;
DI void prologue(KArgs ap, int gw, int NGW, int lane) {
    unsigned char* ws = ap->ws;
    const float *xp = ap->in[0], *xs = ap->in[1], *g_attn = ap->in[7], *w_in = ap->in[8];
    { unsigned* z = (unsigned*)(ws + WS_X1B); for (int i = gw * 64 + lane; i < 2 * DM / 2; i += NGW * 64) z[i] = 0u;
      if (gw == 1) { float* gd = (float*)(ws + WS_GAINS); gd[lane] = ap->in[9][lane]; gd[64 + lane] = ap->in[10][lane]; gd[128 + lane] = ap->in[12][lane]; gd[192 + lane] = ap->in[13][lane]; } }
    { float* rt = (float*)(ws + WS_ROPE);
      for (int e = gw * 64 + lane; e < SEQ * 32; e += NGW * 64) { const int pos = e >> 5, i = e & 31;
          const float inv = exp2f(-(float)i * (13.287712379549449f / 32.f));
          double rev = (double)pos * (double)inv * 0.15915494309189535; rev -= __builtin_rint(rev);
          const float fr_ = (float)rev; rt[2 * e] = __builtin_amdgcn_cosf(fr_); rt[2 * e + 1] = __builtin_amdgcn_sinf(fr_); } }
    for (int it = gw; it < 16 * 36; it += NGW) { const int kb = it / 36, hh = it % 36, bj = lane >> 5, x = lane & 31;
        transpose_item(w_in, NIN, 64 * kb, 64 * hh + lane, (bf16_t*)(ws + WS_WIN), DM, 256 * (hh >> 2) + 128 * bj + 32 * (hh & 3) + x, nullptr); }
    {
        f32x4 gg[4];
#pragma unroll
        for (int j = 0; j < 4; ++j) gg[j] = *((const f32x4*)g_attn + lane + 64 * j);
        bf16_t* XN = (bf16_t*)(ws + WS_XN);
        for (int m = gw; m < MTOK; m += NGW) {
            const f32x4* xr = (const f32x4*)(m < SEQ ? xp + (size_t)m * DM : xs + (size_t)(m - SEQ) * DM) + lane;
            f32x4 v[4]; float s = 0.f;
#pragma unroll
            for (int j = 0; j < 4; ++j) { v[j] = xr[64 * j]; s += (v[j][0] * v[j][0] + v[j][1] * v[j][1]) + (v[j][2] * v[j][2] + v[j][3] * v[j][3]); }
            const float rstd = rsqrtf(wave_sum(s) * (1.f / DM) + EPS);
            u32x2* o8 = (u32x2*)(XN + (size_t)m * DM) + lane;
#pragma unroll
            for (int j = 0; j < 4; ++j) o8[64 * j] = pk4(v[j] * rstd * gg[j]);
        }
    }
}
DI void kc_item(const float* src, int past, int nh, int band, int krows, bf16_t* KF, int item, int lane) {
    const int nrb = past / 32, h = item % nh, rb = (item / nh) % nrb, b = item / (nh * nrb), r = lane & 31, hh = lane >> 5;
    const float* sp = src + (((size_t)b * past + rb * 32 + r) * nh + h) * 64 + 8 * hh;
    bf16_t* d = KF + (((size_t)h * (krows >> 5) + ((SEQ + b * band) >> 5) + rb) * 4 * 64 + lane) * 8;
#pragma unroll
    for (int ds = 0; ds < 4; ++ds) { const f32x4 v0 = *(const f32x4*)(sp + 16 * ds), v1 = *(const f32x4*)(sp + 16 * ds + 4);
        u32x4 o; o.x = pk2(v0[0], v0[1]); o.y = pk2(v0[2], v0[3]); o.z = pk2(v1[0], v1[1]); o.w = pk2(v1[2], v1[3]);
        *(u32x4*)(d + ds * 512) = o; }
}
DI void prologue_b(KArgs ap, int gw, int NGW, int lane) {
    unsigned char* ws = ap->ws;
    const float *cak = ap->in[2], *cav = ap->in[3], *cbk = ap->in[4], *cbv = ap->in[5];
    for (int it = gw; it < NSTREAM * 16 * 8; it += NGW) kc_item(cak, 512, 8, 576, KA_ROWS, (bf16_t*)(ws + WS_KA), it, lane);
    for (int it = gw; it < NSTREAM * 4 * 2; it += NGW) kc_item(cbk, 128, 2, 192, KB_ROWS, (bf16_t*)(ws + WS_KB), it, lane);
    for (int it = gw; it < NSTREAM * 8 * 16; it += NGW) vt_item(cav, 512, 8, 576, KA_ROWS, (bf16_t*)(ws + WS_VTA), it, lane);
    for (int it = gw; it < NSTREAM * 2 * 4; it += NGW) vt_item(cbv, 128, 2, 192, KB_ROWS, (bf16_t*)(ws + WS_VTB), it, lane);
}
constexpr int WI_OUT = 16 * 16, WI_GU = 16 * 88, WI_DN = 44 * 16, WI_ALL = WI_OUT + WI_GU + WI_DN;
DI void weight_item(KArgs ap, int it, int lane) {
    unsigned char* ws = ap->ws;
    int r = it;
    if (r < WI_OUT) { const int kb = r / 16, nb = r % 16; transpose_item(ap->in[15], DM, 64 * kb, 64 * nb + lane, (bf16_t*)(ws + WS_WOUT), DM, 64 * nb + lane, nullptr); return; }
    r -= WI_OUT;
    if (r < WI_GU) { const int kb = r / 88, nb = r % 88; const int L = 64 * nb + lane; const int Lp = L < DFF ? L : L - DFF;
        transpose_item(ap->in[17], NGU, 64 * kb, L, (bf16_t*)(ws + WS_WGU), DM, 256 * (Lp >> 7) + (L < DFF ? 0 : 128) + (Lp & 127), ap->in[16]); return; }
    r -= WI_GU;
    { const int kb = r / 16, nb = r % 16; transpose_item(ap->in[20], DM, 64 * kb, 64 * nb + lane, (bf16_t*)(ws + WS_WDN), DFF, 64 * nb + lane, nullptr); }
}

#define XB_TMO      128
#define XB_XCNT(j)  (256  + 64 * (j))
#define XB_XSUB(j)  (1280 + 64 * (j))
#define XB_XGEN(j)  (2304 + 64 * (j))
#define XB_TOP      3328
#define XB_TOPGEN   3392
#define XCD_BAR_WORDS 3456
#define XB_SPIN_CAP (1u << 22)
DI unsigned xb_ld(unsigned* p)              { return __hip_atomic_load(p, __ATOMIC_RELAXED, __HIP_MEMORY_SCOPE_AGENT); }
DI unsigned xb_add(unsigned* p, unsigned v) { return __hip_atomic_fetch_add(p, v, __ATOMIC_RELAXED, __HIP_MEMORY_SCOPE_AGENT); }
DI unsigned xb_xcc_id() { return (unsigned)__builtin_amdgcn_s_getreg((3 << 11) | 20) & 0xFu; }
#define XB_SPIN(cond, bar) do { unsigned _sp = 0; while (cond) { __builtin_amdgcn_s_sleep(1); \
    if ((++_sp & 255u) == 0u) { if (xb_ld(&(bar)[XB_TMO])) break; if (_sp > XB_SPIN_CAP) { atomicAdd(&(bar)[XB_TMO], 1u); break; } } } } while (0)
struct XcdBarrier { unsigned* bar; unsigned x; volatile LAS unsigned* st; };
DI XcdBarrier xcd_barrier_post(unsigned* bar, volatile LAS unsigned* st) {
    XcdBarrier b; b.bar = bar; b.x = xb_xcc_id(); b.st = st;
    if (threadIdx.x == 0) (void)xb_add(&bar[XB_XCNT(b.x)], 1u);
    return b;
}
DI void xcd_barrier_complete(unsigned* bar, unsigned x, unsigned& nloc, unsigned& nx) {
    const unsigned G = gridDim.x * gridDim.y * gridDim.z;
    unsigned sum, cnt, mine, sp = 0u;
    for (;;) {
        sum = 0u; cnt = 0u; mine = 0u;
#pragma unroll
        for (unsigned j = 0; j < 16; ++j) { const unsigned c = xb_ld(&bar[XB_XCNT(j)]); sum += c; cnt += (c > 0u) ? 1u : 0u; mine = (j == x) ? c : mine; }
        if (sum == G) break;
        __builtin_amdgcn_s_sleep(1);
        if ((++sp & 255u) == 0u) { if (xb_ld(&bar[XB_TMO])) break; if (sp > XB_SPIN_CAP) { atomicAdd(&bar[XB_TMO], 1u); break; } }
    }
    nloc = mine > 0u ? mine : 1u; nx = cnt > 0u ? cnt : 1u;
}
DI void xcd_barrier(const XcdBarrier& b) {
    asm volatile("s_waitcnt vmcnt(0)" ::: "memory");
    __syncthreads();
    if (threadIdx.x == 0) {
        unsigned* bar = b.bar;
        __builtin_amdgcn_s_waitcnt(0);
        unsigned nloc = b.st[0], nx = b.st[1];
        if (nloc == 0u) { xcd_barrier_complete(bar, b.x, nloc, nx); b.st[0] = nloc; b.st[1] = nx; }
        const unsigned old = xb_add(&bar[XB_XSUB(b.x)], 1u);
        const unsigned gen = old / nloc;
        if (old + 1u == (gen + 1u) * nloc) {
            __builtin_amdgcn_fence(__ATOMIC_RELEASE, "agent");
            asm volatile("s_waitcnt vmcnt(0)" ::: "memory");
            const unsigned og = xb_add(&bar[XB_TOP], 1u);
            const unsigned tg = og / nx;
            if (og + 1u == (tg + 1u) * nx) xb_add(&bar[XB_TOPGEN], 1u);
            else XB_SPIN(xb_ld(&bar[XB_TOPGEN]) == tg, bar);
            __builtin_amdgcn_fence(__ATOMIC_ACQUIRE, "agent");
            xb_add(&bar[XB_XGEN(b.x)], 1u);
            asm volatile("s_waitcnt vmcnt(0)" ::: "memory");
        } else {
            XB_SPIN(xb_ld(&bar[XB_XGEN(b.x)]) == gen, bar);
            __builtin_amdgcn_fence(__ATOMIC_ACQUIRE, "agent");
            asm volatile("s_waitcnt vmcnt(0)" ::: "memory");
        }
    }
    __syncthreads();
}

__global__ void __launch_bounds__(512, 2) fwd_kernel(Args a_byval) {
    KArgs kp = (KArgs)__builtin_amdgcn_kernarg_segment_ptr();
#define KP() ({ KArgs _p = kp; asm volatile("" : "+s"(_p)); _p; })
    extern __shared__ __attribute__((aligned(16))) unsigned char lds_raw[];
    LAS unsigned char* lds = (LAS unsigned char*)lds_raw;
    const int tid = threadIdx.x, lane = tid & 63, wave = __builtin_amdgcn_readfirstlane(tid >> 6);
    const int G = gridDim.x, bx = blockIdx.x;
    const int lo = kp->ph_lo, hi = kp->ph_hi;
    unsigned char* ws = kp->ws;
#define IN(k) (lo <= (k) && (k) < hi)
#define SEAM(k) do { if (IN(k) && IN((k) + 1)) { for (int _r = 0; _r < 1 + 4 * (NREP(5) - 1); ++_r) xcd_barrier(bar); } } while (0)
    volatile LAS unsigned* MISC = (volatile LAS unsigned*)(lds + RING_BYTES + 8192);
    if (tid < 4) MISC[tid] = 0u;
    __syncthreads();
    XcdBarrier bar; bar.bar = (unsigned*)(ws + WS_BAR); bar.x = 0; bar.st = MISC;
    if (hi - lo > 1 || lo == 3) bar = xcd_barrier_post((unsigned*)(ws + WS_BAR), MISC);
    if (hi > 1000) cg::this_grid().sync();

    if (IN(0)) { for (int rep = 0; rep < NREP(0); ++rep) prologue(KP(), bx * 8 + wave, G * 8, lane); }
    SEAM(0);
    if (IN(1)) {
        pg8::Gemm g{(const bf16_t*)(ws + WS_XN), (const bf16_t*)(ws + WS_WIN), DM};
        pg8::Order<0> S; S.init(MTOK / 256, NIN / 256, G, bx, DM / 64);
        EpiQKV E{(const float*)(ws + WS_GAINS), ws, KP()->out};
        if (NREP(1) == 2) { EpiNull EN; pg8::gemm_phase<EpiNull, pg8::Order<0>, true>(lds, g, S, EN); }
        pg8::gemm_phase<EpiQKV, pg8::Order<0>, true>(lds, g, S, E);
        if (bx >= 136) prologue_b(KP(), (bx - 136) * 8 + wave, (G - 136) * 8, lane);
    }
    SEAM(1);
    if (IN(2)) {
        LAS float* biasL = (LAS float*)(lds + RING_BYTES + 8448);
        { const float* tab = KP()->in[11]; for (int i = tid; i < 8 * 256; i += 512) { const int h = i >> 8, uu = i & 255; int d = 191 - uu; d = d > 128 ? 128 : d; biasL[i] = tab[h * 257 + d + 128] * LOG2E; } }
        const float* sinks = KP()->in[14];
        __syncthreads();
        volatile LAS unsigned* wctr = (volatile LAS unsigned*)(lds + RING_BYTES + 8192 + 64);
        if (tid == 0) *wctr = 0u;
        __syncthreads();
        for (;;) {
            unsigned k = 0; if (lane == 0) k = __hip_atomic_fetch_add((LAS unsigned*)(lds + RING_BYTES + 8192 + 64), 1u, __ATOMIC_RELAXED, __HIP_MEMORY_SCOPE_WORKGROUP);
            k = __builtin_amdgcn_readfirstlane(k);
            if (k >= 19u * NREP(2)) {
                const int it = bx + 256 * (int)(k - 19u * NREP(2));
                if (it >= WI_ALL) break;
                weight_item(KP(), it, lane); continue; }
            if (k >= 19u) k -= 19u;
            if (k < 10u) { const unsigned i = (unsigned)bx + 256u * (k < 8u ? k : 8u); const int nq = k < 8u ? 2 : 1, qoff = k == 9u ? 32 : 0;
                attn_unit<false>(287 - (int)(i >> 3), (int)(i & 7), qoff, nq, (const bf16_t*)(ws + WS_QA), (const bf16_t*)(ws + WS_KA), (const bf16_t*)(ws + WS_VTA), (bf16_t*)(ws + WS_O), nullptr, biasL, lds + wave * 16384, lane); }
            else { const unsigned i = (unsigned)bx + 256u * (k - 10u); attn_unit<true>(287 - (int)(i >> 3), (int)(i & 7), 0, 2, (const bf16_t*)(ws + WS_QB), (const bf16_t*)(ws + WS_KB), (const bf16_t*)(ws + WS_VTB), (bf16_t*)(ws + WS_O), sinks, biasL, lds + wave * 16384, lane); }
        }
        __syncthreads();
    }
    SEAM(2);
    if (IN(3)) {
        const int v = (bx & 7) * 32 + (bx >> 3), x = bx & 7, j = bx >> 3;
#pragma unroll 1
        for (int step = 0; step < 6; ++step) {
            int kind, rs, rstr = 32, rc;
            if (step == 0) { kind = 3; rs = v; rc = 1; }
            else if (step == 1) { kind = 3; rs = 256 + 4 * x + j; rc = j < 4 ? 1 : 0; }
            else if (step == 2) { kind = 4; if (j < 4) { rs = 92 * x + 28 + j; rc = 2; } else { rs = 92 * x + j - 4; rc = 3; } }
            else if (step == 3) { kind = 5; rs = 4 * x + j; rc = j < 4 ? 1 : 0; }
            else if (step == 4) { kind = 4; const int base = 736 + (x < 6 ? 109 * x : 654 + 108 * (x - 6)), r = (x < 6 ? 21 : 20);
                if (j < 4) { rs = base + j; rc = 1; } else { const int jj = j - 4; rs = base + 4 + jj; rstr = 28; rc = 3 + (jj < r ? 1 : 0); } }
            else { kind = 5; rs = 32 + v; rc = 1; }
            if (kind == 3) {
                pg8::Gemm g{(const bf16_t*)(ws + WS_O), (const bf16_t*)(ws + WS_WOUT), DM};
                pg8::RangeOrder<3> S{rs, rstr, rc};
                KArgs q = KP(); EpiOut E{q->in[0], q->in[1], q->out, (bf16_t*)(ws + WS_X1B), (float*)(ws + WS_SUMSQ)};
                if (NREP(8) == 2) { EpiNull EN; pg8::gemm_phase<EpiNull, pg8::RangeOrder<3>, true>(lds, g, S, EN); }
                pg8::gemm_phase<EpiOut, pg8::RangeOrder<3>, true>(lds, g, S, E);
            } else if (kind == 4) {
                pg8::Gemm g{(const bf16_t*)(ws + WS_X1B), (const bf16_t*)(ws + WS_WGU), DM};
                pg8::RangeOrder<4> S{rs, rstr, rc};
                KArgs q = KP(); EpiGU E{(const float*)(ws + WS_SUMSQ), q->in[18], q->in[19], q->in[6], (bf16_t*)(ws + WS_Y), q->out};
#pragma nounroll
                for (int rep = 0; rep < NREP(3); ++rep) pg8::gemm_phase<EpiGU, pg8::RangeOrder<4>, true>(lds, g, S, E);
            } else {
                pg8::Gemm g{(const bf16_t*)(ws + WS_Y), (const bf16_t*)(ws + WS_WDN), DFF};
                pg8::RangeOrder<5> S{rs, rstr, rc};
                EpiDown E{KP()->out, (const bf16_t*)(ws + WS_X1B)};
                if (NREP(9) == 2) { EpiNull EN; pg8::gemm_phase<EpiNull, pg8::RangeOrder<5>, true>(lds, g, S, EN); }
                pg8::gemm_phase<EpiDown, pg8::RangeOrder<5>, true>(lds, g, S, E);
            }
            if (step == 0 || step == 2 || step == 4) xcd_barrier(bar);
        }
    }
#undef IN
#undef SEAM
}

extern "C" void kernel_launch(void* const* d_in, const int* in_sizes, int n_in, void* d_out, int out_size, void* d_ws, size_t ws_size, hipStream_t stream) {
    static int grid = 0;
    if (grid == 0) {
        int dev = 0, cus = 0, per_cu = 0;
        hipGetDevice(&dev);
        hipDeviceGetAttribute(&cus, hipDeviceAttributeMultiprocessorCount, dev);
        if (hipFuncSetAttribute((const void*)fwd_kernel, hipFuncAttributeMaxDynamicSharedMemorySize, LDS_BYTES) != hipSuccess) { fprintf(stderr, "hipFuncSetAttribute failed\n"); grid = -1; return; }
        if (hipOccupancyMaxActiveBlocksPerMultiprocessor(&per_cu, (const void*)fwd_kernel, 512, LDS_BYTES) != hipSuccess || per_cu < 1) { fprintf(stderr, "occupancy query: %d\n", per_cu); per_cu = 1; }
        (void)hipGetLastError();
        grid = 256;
        if (cus != 256) fprintf(stderr, "note: device reports %d CUs; this kernel is laid out for 256\n", cus);
        if (n_in != 21 || ws_size < 256 * MiB) { fprintf(stderr, "unexpected n_in %d / ws %zu\n", n_in, ws_size); grid = -1; return; }
    }
    if (grid < 0) return;
    if (hipMemsetAsync((char*)d_ws + WS_CTL, 0, CTL_ZERO_BYTES, stream) != hipSuccess) { fprintf(stderr, "memset failed\n"); return; }
    Args a{};
    for (int i = 0; i < 21; ++i) a.in[i] = (const float*)d_in[i];
    a.out = (float*)d_out; a.ws = (unsigned char*)d_ws;
#if N_LAUNCH_MODE == 1
    a.ph_lo = 0; a.ph_hi = 4;
    void* args[] = {&a};
    hipError_t e = hipLaunchCooperativeKernel((const void*)fwd_kernel, dim3(grid), dim3(512), args, LDS_BYTES, stream);
    if (e != hipSuccess) fprintf(stderr, "cooperative launch failed: %s (grid %d)\n", hipGetErrorString(e), grid);
#else
    for (int p = 0; p < 4; ++p) { a.ph_lo = p; a.ph_hi = p + 1; hipLaunchKernelGGL(fwd_kernel, dim3(grid), dim3(512), LDS_BYTES, stream, a); }
#endif
}
```

```cpp
#include <hip/hip_runtime.h>
#include <hip/hip_cooperative_groups.h>
#include <cstdio>
#include <cstdint>
namespace cg = cooperative_groups;

#ifndef N_LAUNCH_MODE
#define N_LAUNCH_MODE 1
#endif

#ifndef REP
#define REP 0
#endif
#define NREP(k) ((((REP) >> (k)) & 1) + 1)
#ifndef PROBE_EPI
#define PROBE_EPI 1
#endif
#define LAS __attribute__((address_space(3)))
#define DI __device__ __forceinline__
typedef unsigned short bf16_t;
typedef short bf16x8 __attribute__((ext_vector_type(8)));
typedef short s16x4 __attribute__((ext_vector_type(4)));
typedef float f32x4 __attribute__((ext_vector_type(4)));
typedef float f32x16 __attribute__((ext_vector_type(16)));
typedef unsigned u32x4 __attribute__((ext_vector_type(4)));
typedef unsigned u32x2 __attribute__((ext_vector_type(2)));

constexpr int DM = 1024, SEQ = 16384, NSTREAM = 32, DSEQ = 64, MTOK = SEQ + NSTREAM * DSEQ;
constexpr int NIN = 2304, DFF = 2816, NGU = 2 * DFF;
constexpr int KA_ROWS = SEQ + NSTREAM * 576;
constexpr int KB_ROWS = SEQ + NSTREAM * 192;
constexpr int X1B_PROMPT_ROWS = 16512;
constexpr int GU_PT = 65;
constexpr float EPS = 1e-6f, LOG2E = 1.4426950408889634f;
constexpr float QSCALE = 0.125f * LOG2E;
constexpr size_t OFF_AKP = 18874368, OFF_AVP = 19136512, OFF_BKP = 19398656, OFF_BVP = 19415040, OFF_CVP = 19431424;
constexpr size_t OFF_AKS = 19437056, OFF_AVS = 20485632, OFF_BKS = 21534208, OFF_BVS = 21796352, OFF_CVS = 22058496;
constexpr size_t MiB = 1u << 20;
constexpr size_t WS_CTL = 0, WS_GAINS = 4096, WS_BAR = 16384, WS_SUMSQ = 65536, CTL_ZERO_BYTES = 160 * 1024;
constexpr size_t WS_WIN = 1 * MiB, WS_WOUT = 6 * MiB, WS_WGU = 8 * MiB, WS_WDN = 19 * MiB;
constexpr size_t WS_X1B = 25 * MiB, WS_O = 62 * MiB, WS_VTA = 98 * MiB, WS_KB = 132 * MiB, WS_VTB = 138 * MiB;
constexpr size_t WS_XN = 144 * MiB, WS_QA = 180 * MiB, WS_QB = 198 * MiB, WS_KA = 216 * MiB;
constexpr size_t WS_ROPE = 250 * MiB;
constexpr size_t WS_Y = 144 * MiB;
constexpr int LDS_BYTES = 155648, RING_BYTES = 131072;

struct Args { const float* in[21]; float* out; unsigned char* ws; int ph_lo, ph_hi; };

DI unsigned pk2(float lo, float hi) {
    typedef float f2 __attribute__((ext_vector_type(2))); typedef __bf16 b2 __attribute__((ext_vector_type(2)));
    f2 v = {lo, hi}; b2 b = __builtin_convertvector(v, b2); return __builtin_bit_cast(unsigned, b);
}
DI size_t kf_off(int h, int nblk, int krow, int d) { return ((((size_t)h * nblk + (krow >> 5)) * 4 + (d >> 4)) * 64 + ((d >> 3) & 1) * 32 + (krow & 31)) * 8 + (d & 7); }
DI size_t vf_off(int h, int nblk, int krow, int d) { const int kk = krow & 31; return (((((size_t)h * nblk + (krow >> 5)) * 2 + (d >> 5)) * 2 + (kk >> 4)) * 64 + ((kk >> 2) & 1) * 32 + (d & 31)) * 8 + 4 * ((kk >> 3) & 1) + (kk & 3); }
DI u32x2 pk4(f32x4 v) { u32x2 r; r.x = pk2(v[0], v[1]); r.y = pk2(v[2], v[3]); return r; }

namespace pg8 {
constexpr int BM = 256, BK = 64, HALF = 128, HTB = HALF * BK * 2, NXCD = 8, WGM = 8;
DI int lds_byte(int r, int c) { const int st = (r >> 4) * 2 + (c >> 5), rr = r & 15, cc = c & 31, ob = rr * 64 + cc * 2; return st * 1024 + (ob ^ (((ob >> 9) & 1) << 5)); }
DI void stage_rc(int b, int& R, int& C) { const int st = b / 1024, sb = b % 1024, swz = sb ^ (((sb >> 9) & 1) << 5); R = (st >> 1) * 16 + swz / 64; C = (st & 1) * 32 + (swz % 64) / 2; }

struct Unit { int pm, pn, kt0, nkt; };
struct Gemm { const bf16_t* A; const bf16_t* Bt; int K; };

template <int GU> struct Order {
    int nM, nN, nwg, G, c, nkt;
    DI void init(int nM_, int nN_, int G_, int c_, int nkt_) { nM = nM_; nN = nN_; nwg = nM * nN; G = G_; c = c_; nkt = nkt_; }
    DI bool next(int i, Unit& u) const {
        const long L = (long)i * G + c; if (L >= nwg) return false;
        u.kt0 = 0; u.nkt = nkt;
        int wgid = (int)L; { const int q = nwg / NXCD, r = nwg % NXCD, xcd = wgid % NXCD, off = wgid / NXCD; wgid = (xcd < r ? xcd * (q + 1) : r * (q + 1) + (xcd - r) * q) + off; }
        const int nig = WGM * nN, gid = wgid / nig, fm = gid * WGM, gsz = (nM - fm) < WGM ? (nM - fm) : WGM;
        u.pm = fm + ((wgid % nig) % gsz); u.pn = (wgid % nig) / gsz; return true;
    }
    DI size_t a_row(int pm) const { return GU ? (size_t)(pm < GU_PT ? 254 * pm : X1B_PROMPT_ROWS + 256 * (pm - GU_PT)) : (size_t)pm * 256; }
};

template <int KIND> struct RangeOrder {
    int s, stride, cnt;
    DI bool next(int i, Unit& u) const {
        if (i >= cnt) return false;
        const int idx = s + i * stride;
        if (KIND == 4) { const int g = idx / 176, w = idx - 176 * g, gsz = (73 - 8 * g) < 8 ? (73 - 8 * g) : 8;
            u.pm = 8 * g + w % gsz; u.pn = w / gsz; u.kt0 = 0; u.nkt = 16; }
        else { u.pm = idx >> 2; u.pn = idx & 3; u.kt0 = 0; u.nkt = KIND == 5 ? 44 : 16; }
        return true;
    }
    DI size_t a_row(int pm) const { return KIND == 4 ? (size_t)(pm < GU_PT ? 254 * pm : X1B_PROMPT_ROWS + 256 * (pm - GU_PT)) : (size_t)pm * 256; }
};
struct OrderSK {
    static constexpr int NP = 22, NU = 288;
    int s, e;
    DI void init(int G, int c) { const int v = (G % 8 == 0) ? (c % 8) * (G / 8) + c / 8 : c; s = (int)((long)v * (NU * NP) / G); e = (int)((long)(v + 1) * (NU * NP) / G); }
    DI bool next(int i, Unit& u) const {
        int p = s;
        for (int k = 0; k < i; ++k) p = (p / NP + 1) * NP;
        if (p >= e) return false;
        const int unit = p / NP, pe = (unit + 1) * NP < e ? (unit + 1) * NP : e;
        u.kt0 = (p - unit * NP) * 2; u.nkt = (pe - p) * 2;
        u.pm = (unit >> 5) * 8 + (unit & 7); u.pn = (unit & 31) >> 3; return true;
    }
    DI size_t a_row(int pm) const { return (size_t)pm * 256; }
};

template <class Epi, class Sched, bool ALIGN_EPI>
DI void gemm_phase(LAS unsigned char* lds, const Gemm g, const Sched& S, const Epi& E) {
    const int tid = threadIdx.x, wid = __builtin_amdgcn_readfirstlane(tid >> 6), lane = tid & 63, wr = wid >> 2, wc = wid & 3, fr = lane & 15, fq = lane >> 4;
    const int K = g.K;
    unsigned voffA[2];
#pragma unroll
    for (int i = 0; i < 2; ++i) { int R, C; stage_rc(tid * 16 + i * 8192, R, C); voffA[i] = (unsigned)(R * K + C) * 2u; }
    const size_t kstep = (size_t)(BK * 2);
    const size_t hstep = (size_t)HALF * K * 2;
    const size_t rowb = (size_t)K * 2;
    const unsigned ldsw = (unsigned)wid * 1024u;
    const int aoff = lds_byte(wr * 64 + fr, fq * 8), boff = lds_byte(wc * 32 + fr, fq * 8);
#define PG8_SA(b, h) (((b) * 2 + (h)) * HTB)
#define PG8_SB(b, h) ((4 + (b) * 2 + (h)) * HTB)
#define PG8_STAGE(bufoff, gbase, voff) do { _Pragma("unroll") for (int _i = 0; _i < 2; ++_i) \
        __builtin_amdgcn_global_load_lds((const unsigned*)((const char*)(gbase) + (voff)[_i]), (LAS unsigned*)(lds + (bufoff) + ldsw + _i * 8192), 16, 0, 0); } while (0)
#define PG8_LDA(dst, b, h) do { _Pragma("unroll") for (int m = 0; m < 4; ++m) _Pragma("unroll") for (int k = 0; k < 2; ++k) dst[m][k] = *(const LAS bf16x8*)(lds + PG8_SA(b, h) + aoff + m * 2048 + k * 1024); } while (0)
#define PG8_LDB(dst, b, h) do { _Pragma("unroll") for (int n = 0; n < 2; ++n) _Pragma("unroll") for (int k = 0; k < 2; ++k) dst[n][k] = *(const LAS bf16x8*)(lds + PG8_SB(b, h) + boff + n * 2048 + k * 1024); } while (0)
#define PG8_MMA(ai, bj, At, Bt) do { __builtin_amdgcn_s_setprio(1); _Pragma("unroll") for (int m = 0; m < 4; ++m) _Pragma("unroll") for (int n = 0; n < 2; ++n) _Pragma("unroll") for (int k = 0; k < 2; ++k) \
        acc[ai][bj][m][n] = __builtin_amdgcn_mfma_f32_16x16x32_bf16(Bt[n][k], At[m][k], acc[ai][bj][m][n], 0, 0, 0); __builtin_amdgcn_s_setprio(0); } while (0)
#define PG8_WAIT_V(n) asm volatile("s_waitcnt vmcnt(" #n ")" ::: "memory")
#define PG8_WAIT_L(n) asm volatile("s_waitcnt lgkmcnt(" #n ")" ::: "memory")
#define PG8_BAR __builtin_amdgcn_s_barrier()
#define PG8_SCHED __builtin_amdgcn_sched_barrier(0)
    Unit cur, nxt; int ui = 0;
    if (!S.next(0, cur)) return;
    f32x4 acc[2][2][4][2];
#pragma unroll
    for (int a = 0; a < 2; ++a)
#pragma unroll
        for (int b = 0; b < 2; ++b)
#pragma unroll
            for (int m = 0; m < 4; ++m)
#pragma unroll
                for (int n = 0; n < 2; ++n) acc[a][b][m][n] = (f32x4){0.f, 0.f, 0.f, 0.f};
    bf16x8 At[4][2], B0[2][2], B1[2][2];
    const char* cA = (const char*)g.A + S.a_row(cur.pm) * rowb + (size_t)cur.kt0 * kstep; const char* cB = (const char*)g.Bt + (size_t)cur.pn * 2 * hstep + (size_t)cur.kt0 * kstep;
    PG8_STAGE(PG8_SB(0, 0), cB, voffA); PG8_STAGE(PG8_SB(0, 1), cB + hstep, voffA); PG8_STAGE(PG8_SA(0, 0), cA, voffA); PG8_STAGE(PG8_SA(0, 1), cA + hstep, voffA);
    if (wr == 1) PG8_BAR;
    PG8_WAIT_V(2); PG8_BAR;
    PG8_STAGE(PG8_SB(1, 0), cB + kstep, voffA); PG8_STAGE(PG8_SA(1, 0), cA + kstep, voffA); PG8_STAGE(PG8_SB(1, 1), cB + hstep + kstep, voffA);
    PG8_WAIT_V(6); PG8_BAR;
    for (;;) {
        const bool has_next = S.next(ui + 1, nxt);
        const char* nA = has_next ? (const char*)g.A + S.a_row(nxt.pm) * rowb + (size_t)nxt.kt0 * kstep : cA; const char* nB = has_next ? (const char*)g.Bt + (size_t)nxt.pn * 2 * hstep + (size_t)nxt.kt0 * kstep : cB;
        const int nt = cur.nkt;
        for (int t = 0; t < nt; t += 2) {
            const bool last = (t == nt - 2);
            const char* a1 = cA + (size_t)(t + 1) * kstep;
            const char* a2 = last ? nA : cA + (size_t)(t + 2) * kstep; const char* b2 = last ? nB : cB + (size_t)(t + 2) * kstep;
            const char* a3 = a2 + kstep; const char* b3 = b2 + kstep;
            PG8_LDB(B0, 0, 0); PG8_LDB(B1, 0, 1); PG8_SCHED; PG8_LDA(At, 0, 0); PG8_STAGE(PG8_SA(1, 1), a1 + hstep, voffA);
            PG8_WAIT_V(8); PG8_WAIT_L(0); PG8_BAR; PG8_MMA(0, 0, At, B0); PG8_MMA(0, 1, At, B1); PG8_BAR; PG8_SCHED;
            PG8_LDA(At, 0, 1); PG8_STAGE(PG8_SB(0, 0), b2, voffA); PG8_STAGE(PG8_SB(0, 1), b2 + hstep, voffA); PG8_STAGE(PG8_SA(0, 0), a2, voffA);
            PG8_WAIT_V(8); PG8_WAIT_L(0); PG8_BAR; PG8_MMA(1, 0, At, B0); PG8_MMA(1, 1, At, B1); PG8_BAR; PG8_SCHED;
            PG8_LDB(B0, 1, 0); PG8_LDB(B1, 1, 1); PG8_SCHED; PG8_LDA(At, 1, 0); PG8_STAGE(PG8_SA(0, 1), a2 + hstep, voffA);
            PG8_WAIT_V(8); PG8_WAIT_L(0); PG8_BAR; PG8_MMA(0, 0, At, B0); PG8_MMA(0, 1, At, B1); PG8_BAR; PG8_SCHED;
            PG8_LDA(At, 1, 1); PG8_STAGE(PG8_SB(1, 0), b3, voffA); PG8_STAGE(PG8_SB(1, 1), b3 + hstep, voffA); PG8_STAGE(PG8_SA(1, 0), a3, voffA);
            PG8_WAIT_V(8); PG8_WAIT_L(0); PG8_BAR; PG8_MMA(1, 0, At, B0); PG8_MMA(1, 1, At, B1); PG8_BAR; PG8_SCHED;
        }
        if constexpr (ALIGN_EPI) { if (wr == 0) PG8_BAR; }
        E(acc, cur, wr, wc, fr, fq, lds + RING_BYTES);
        if constexpr (NREP(7) == 2 && Epi::PROBE2) E(acc, cur, wr, wc, fr, fq, lds + RING_BYTES);
        if (!has_next) break;
#pragma unroll
        for (int a = 0; a < 2; ++a)
#pragma unroll
            for (int b = 0; b < 2; ++b)
#pragma unroll
                for (int m = 0; m < 4; ++m)
#pragma unroll
                    for (int n = 0; n < 2; ++n) acc[a][b][m][n] = (f32x4){0.f, 0.f, 0.f, 0.f};
        cur = nxt; cA = nA; cB = nB; ++ui;
        if constexpr (ALIGN_EPI) { if (wr == 1) PG8_BAR; }
    }
    PG8_WAIT_V(0);
    if constexpr (!ALIGN_EPI) { if (wr == 0) PG8_BAR; }
    PG8_BAR;
#undef PG8_SA
#undef PG8_SB
#undef PG8_STAGE
#undef PG8_LDA
#undef PG8_LDB
#undef PG8_MMA
#undef PG8_WAIT_V
#undef PG8_WAIT_L
#undef PG8_BAR
#undef PG8_SCHED
}
}
using pg8::Unit;
typedef f32x4 AccT[2][2][4][2];

struct EpiQKV {
    static constexpr bool PROBE2 = (PROBE_EPI == 1);
    const float* gains;
    unsigned char* ws; float* out;
    DI void operator()(const AccT& acc, const Unit& u, int wr, int wc, int fr, int fq, LAS unsigned char*) const {
        const int hh = u.pn * 4 + wc;
        int kind, h;
        if (hh < 8) { kind = 0; h = hh; } else if (hh < 16) { kind = 1; h = hh - 8; } else if (hh < 24) { kind = 2; h = hh - 16; }
        else if (hh < 32) { kind = 3; h = hh - 24; } else if (hh < 34) { kind = 4; h = hh - 32; } else { kind = 5; h = hh - 34; }
        const bool donorm = (kind != 2 && kind != 5), dorope = (kind == 3 || kind == 4);
        const float* gain = gains + 64 * (kind == 0 ? 0 : (kind == 1 ? 1 : (kind == 3 ? 2 : 3)));
        f32x4 gv[2][2];
#pragma unroll
        for (int bj = 0; bj < 2; ++bj)
#pragma unroll
            for (int n = 0; n < 2; ++n) gv[bj][n] = donorm ? *(const f32x4*)(gain + 32 * bj + 16 * n + 4 * fq) : (f32x4){1.f, 1.f, 1.f, 1.f};
#pragma unroll
        for (int ai = 0; ai < 2; ++ai)
#pragma unroll
            for (int m = 0; m < 4; ++m) {
                const int row = u.pm * 256 + ai * 128 + wr * 64 + m * 16 + fr;
                f32x4 v[2][2];
#pragma unroll
                for (int bj = 0; bj < 2; ++bj)
#pragma unroll
                    for (int n = 0; n < 2; ++n) v[bj][n] = acc[ai][bj][m][n];
                if (donorm) {
                    float ss = 0.f;
#pragma unroll
                    for (int bj = 0; bj < 2; ++bj)
#pragma unroll
                        for (int n = 0; n < 2; ++n) ss += (v[bj][n][0] * v[bj][n][0] + v[bj][n][1] * v[bj][n][1]) + (v[bj][n][2] * v[bj][n][2] + v[bj][n][3] * v[bj][n][3]);
                    ss += __shfl_xor(ss, 16); ss += __shfl_xor(ss, 32);
                    const float rs = rsqrtf(ss * (1.f / 64.f) + EPS);
#pragma unroll
                    for (int bj = 0; bj < 2; ++bj)
#pragma unroll
                        for (int n = 0; n < 2; ++n) v[bj][n] = v[bj][n] * rs * gv[bj][n];
                }
                if (dorope) {
                    const int pos = row < SEQ ? row : 1024 + ((row - SEQ) & 63);
                    const f32x4* rt = (const f32x4*)((const float*)(ws + WS_ROPE) + ((size_t)pos * 32 + 4 * fq) * 2);
#pragma unroll
                    for (int n = 0; n < 2; ++n) {
                        const f32x4 t0 = rt[8 * n], t1 = rt[8 * n + 1];
                        const float cs[4] = {t0[0], t0[2], t1[0], t1[2]}, sn[4] = {t0[1], t0[3], t1[1], t1[3]};
#pragma unroll
                        for (int j = 0; j < 4; ++j) { const float x1 = v[0][n][j], x2 = v[1][n][j]; v[0][n][j] = x1 * cs[j] - x2 * sn[j]; v[1][n][j] = x2 * cs[j] + x1 * sn[j]; }
                    }
                }
                if (kind == 0 || kind == 3) {
                    bf16_t* q = (bf16_t*)(ws + (kind == 0 ? WS_QA : WS_QB)) + ((size_t)h * MTOK + row) * 64 + 4 * fq;
#pragma unroll
                    for (int bj = 0; bj < 2; ++bj)
#pragma unroll
                        for (int n = 0; n < 2; ++n) *(u32x2*)(q + 32 * bj + 16 * n) = pk4(v[bj][n] * QSCALE);
                } else {
                    const bool isA = (kind == 1 || kind == 2), isK = (kind == 1 || kind == 4);
                    const int srow = row - SEQ;
                    const int band = isA ? 576 : 192, past = isA ? 512 : 128, nh = isA ? 8 : 2;
                    const int krow = row < SEQ ? row : SEQ + (srow >> 6) * band + past + (srow & 63);
                    const int krows = isA ? KA_ROWS : KB_ROWS;
                    float* op = nullptr;
                    size_t ooff = 0; bool has_o = false;
                    if (row >= SEQ) { ooff = (isA ? (isK ? OFF_AKS : OFF_AVS) : (isK ? OFF_BKS : OFF_BVS)) + ((size_t)srow * nh + h) * 64; has_o = true; }
                    else if (row >= SEQ - past) { ooff = (isA ? (isK ? OFF_AKP : OFF_AVP) : (isK ? OFF_BKP : OFF_BVP)) + ((size_t)(row - (SEQ - past)) * nh + h) * 64; has_o = true; }
                    op = out + ooff;
                    if (has_o) {
#pragma unroll
                        for (int bj = 0; bj < 2; ++bj)
#pragma unroll
                            for (int n = 0; n < 2; ++n) *(f32x4*)(op + 32 * bj + 16 * n + 4 * fq) = v[bj][n];
                    }
                    if (isK) {
                        bf16_t* kp = (bf16_t*)(ws + (isA ? WS_KA : WS_KB));
#pragma unroll
                        for (int bj = 0; bj < 2; ++bj)
#pragma unroll
                            for (int n = 0; n < 2; ++n) *(u32x2*)(kp + kf_off(h, krows >> 5, krow, 32 * bj + 16 * n + 4 * fq)) = pk4(v[bj][n]);
                    } else {
                        bf16_t* vp = (bf16_t*)(ws + (isA ? WS_VTA : WS_VTB));
#pragma unroll
                        for (int bj = 0; bj < 2; ++bj)
#pragma unroll
                            for (int n = 0; n < 2; ++n)
#pragma unroll
                                for (int j = 0; j < 4; ++j) {
                                    const float mine = v[bj][n][j], oth = __shfl_xor(mine, 1);
                                    if (!(fr & 1)) *(unsigned*)(vp + vf_off(h, krows >> 5, krow, 32 * bj + 16 * n + 4 * fq + j)) = pk2(mine, oth);
                                }
                    }
                }
            }
    }
};

struct EpiNull {
    static constexpr bool PROBE2 = false;
    DI void operator()(const AccT& acc, const Unit& u, int wr, int wc, int fr, int fq, LAS unsigned char*) const {
#pragma unroll
        for (int ai = 0; ai < 2; ++ai)
#pragma unroll
            for (int bj = 0; bj < 2; ++bj)
#pragma unroll
                for (int m = 0; m < 4; ++m)
#pragma unroll
                    for (int n = 0; n < 2; ++n) asm volatile("" :: "v"(acc[ai][bj][m][n]));
    }
};
struct EpiOut {
    static constexpr bool PROBE2 = false;
    const float *xp, *xs; float* out; bf16_t* X1B; float* sumsq;
    DI void operator()(const AccT& acc, const Unit& u, int wr, int wc, int fr, int fq, LAS unsigned char*) const {
        const int col0 = u.pn * 256 + wc * 32 + 4 * fq;
#pragma unroll
        for (int ai = 0; ai < 2; ++ai)
#pragma unroll
            for (int m = 0; m < 4; ++m) {
                const int row = u.pm * 256 + ai * 128 + wr * 64 + m * 16 + fr;
                const float* xr = (row < SEQ ? xp + (size_t)row * DM : xs + (size_t)(row - SEQ) * DM) + col0;
                bf16_t* brow = X1B + (size_t)(row < SEQ ? row + 2 : row + (X1B_PROMPT_ROWS - SEQ)) * DM + col0;
                float ss = 0.f;
#pragma unroll
                for (int bj = 0; bj < 2; ++bj)
#pragma unroll
                    for (int n = 0; n < 2; ++n) {
                        const int c = bj * 128 + n * 16;
                        const f32x4 o = *(const f32x4*)(xr + c) + acc[ai][bj][m][n];
                        *(u32x2*)(brow + c) = pk4(o);
                        ss += (o[0] * o[0] + o[1] * o[1]) + (o[2] * o[2] + o[3] * o[3]);
                    }
                ss += __shfl_xor(ss, 16); ss += __shfl_xor(ss, 32);
                if (fq == 0) unsafeAtomicAdd(sumsq + row, ss);
            }
    }
};

struct EpiGU {
    static constexpr bool PROBE2 = (PROBE_EPI == 4);
    const float *sumsq, *convw, *convb, *state; bf16_t* Y; float* out;
    DI void operator()(const AccT& acc, const Unit& u, int wr, int wc, int fr, int fq, LAS unsigned char* ldsx) const {
        LAS float* H = (LAS float*)ldsx;
        const int T = u.pm; const bool prompt = T < GU_PT; const int lane = fq * 16 + fr;
        const int tok0 = (prompt ? 254 * T - 2 : SEQ + 256 * (T - GU_PT)) + 64 * wr + fr;
        f32x4 w0[2], w1[2], w2[2], cb[2];
#pragma unroll
        for (int n = 0; n < 2; ++n) { const int f = u.pn * 128 + wc * 32 + 16 * n + 4 * fq;
            w0[n] = *(const f32x4*)(convw + f); w1[n] = *(const f32x4*)(convw + DFF + f); w2[n] = *(const f32x4*)(convw + 2 * DFF + f); cb[n] = *(const f32x4*)(convb + f); }
        float rs[2][4];
#pragma unroll
        for (int ai = 0; ai < 2; ++ai)
#pragma unroll
            for (int m = 0; m < 4; ++m) { const int tok = tok0 + 128 * ai + 16 * m; const bool ok = tok >= 0 && tok < (prompt ? SEQ : MTOK);
                rs[ai][m] = ok ? rsqrtf(sumsq[ok ? tok : 0] * (1.f / DM) + EPS) : 0.f; }
        if (prompt) {
            if (fr >= 14) {
#pragma unroll
                for (int ai = 0; ai < 2; ++ai)
#pragma unroll
                    for (int n = 0; n < 2; ++n) *(LAS f32x4*)(H + ((ai * 2 + wr) * 4 + wc) * 64 + (fr - 14) * 32 + 16 * n + 4 * fq) = acc[ai][0][3][n] * rs[ai][3];
            }
            asm volatile("s_waitcnt lgkmcnt(0)" ::: "memory"); __builtin_amdgcn_s_barrier(); asm volatile("" ::: "memory");
        }
#pragma unroll
        for (int n = 0; n < 2; ++n) {
            const int f = u.pn * 128 + wc * 32 + 16 * n + 4 * fq;
#pragma unroll
            for (int ai = 0; ai < 2; ++ai) {
                f32x4 hm1 = {0.f, 0.f, 0.f, 0.f}, hm2 = {0.f, 0.f, 0.f, 0.f};
                const int sb = 4 * (T - GU_PT) + 2 * ai + wr;
                if (prompt) {
                    if (ai | wr) { const int sai = wr ? ai : ai - 1, swr = wr ^ 1; const LAS float* hp = H + ((sai * 2 + swr) * 4 + wc) * 64 + 16 * n + 4 * fq;
                        hm2 = *(const LAS f32x4*)hp; hm1 = *(const LAS f32x4*)(hp + 32); }
                } else { hm2 = *(const f32x4*)(state + (size_t)(sb * 2) * DFF + f); hm1 = *(const f32x4*)(state + (size_t)(sb * 2 + 1) * DFF + f); }
                f32x4 p1 = hm1, p2;
#pragma unroll
                for (int j = 0; j < 4; ++j) p2[j] = fr == 1 ? hm1[j] : hm2[j];
#pragma unroll
                for (int m = 0; m < 4; ++m) {
                    const f32x4 g = acc[ai][0][m][n] * rs[ai][m];
                    f32x4 gm1, gm2;
#pragma unroll
                    for (int j = 0; j < 4; ++j) {
                        gm1[j] = __int_as_float(__builtin_amdgcn_update_dpp(__float_as_int(p1[j]), __float_as_int(g[j]), 0x111, 0xf, 0xf, false));
                        gm2[j] = __int_as_float(__builtin_amdgcn_update_dpp(__float_as_int(p2[j]), __float_as_int(g[j]), 0x112, 0xf, 0xf, false));
                        if (m < 3) {
                            p1[j] = __int_as_float(__builtin_amdgcn_update_dpp(0, __float_as_int(g[j]), 0x121, 0xf, 0xf, false));
                            p2[j] = __int_as_float(__builtin_amdgcn_update_dpp(0, __float_as_int(g[j]), 0x122, 0xf, 0xf, false)); }
                    }
                    const f32x4 cv = cb[n] + w0[n] * gm2 + w1[n] * gm1 + w2[n] * g;
                    const f32x4 up = acc[ai][1][m][n] * rs[ai][m];
                    f32x4 y;
#pragma unroll
                    for (int j = 0; j < 4; ++j) y[j] = cv[j] * __builtin_amdgcn_rcpf(1.f + __builtin_amdgcn_exp2f(-cv[j] * LOG2E)) * up[j];
                    const int tok = tok0 + 128 * ai + 16 * m;
                    const int rloc = 128 * ai + 64 * wr + 16 * m + fr;
                    const bool ok = prompt ? (rloc >= 2 && tok < SEQ) : true;
                    if (ok) *(u32x2*)(Y + (size_t)tok * DFF + f) = pk4(y);
                    if (prompt) { if (tok == SEQ - 2 || tok == SEQ - 1) *(f32x4*)(out + OFF_CVP + (size_t)(tok - (SEQ - 2)) * DFF + f) = g; }
                    else if (m == 3 && fr >= 14) *(f32x4*)(out + OFF_CVS + (size_t)(sb * 2 + (fr - 14)) * DFF + f) = g;
                }
            }
        }
    }
};

struct EpiDown {
    static constexpr bool PROBE2 = false;
    float* out; const bf16_t* X1B;
    DI void operator()(const AccT& acc, const Unit& u, int wr, int wc, int fr, int fq, LAS unsigned char*) const {
        const int col0 = u.pn * 256 + wc * 32 + 4 * fq;
#pragma unroll
        for (int ai = 0; ai < 2; ++ai)
#pragma unroll
            for (int m = 0; m < 4; ++m) {
                const int row = u.pm * 256 + ai * 128 + wr * 64 + m * 16 + fr;
                float* orow = out + (size_t)row * DM + col0;
                const bf16_t* brow = X1B + (size_t)(row < SEQ ? row + 2 : row + (X1B_PROMPT_ROWS - SEQ)) * DM + col0;
#pragma unroll
                for (int bj = 0; bj < 2; ++bj)
#pragma unroll
                    for (int n = 0; n < 2; ++n) { const int c = bj * 128 + n * 16; const u32x2 xb = *(const u32x2*)(brow + c);
                        const f32x4 xr = {__uint_as_float(xb.x << 16), __uint_as_float(xb.x & 0xffff0000u), __uint_as_float(xb.y << 16), __uint_as_float(xb.y & 0xffff0000u)};
                        *(f32x4*)(orow + c) = xr + acc[ai][bj][m][n]; }
            }
    }
};

#define MFMA32(a, b, c) __builtin_amdgcn_mfma_f32_32x32x16_bf16((a), (b), (c), 0, 0, 0)
DI void kv_dma(const bf16_t* Kg, const bf16_t* Vg, int blk, LAS unsigned char* slot) {
#pragma unroll
    for (int f = 0; f < 4; ++f) __builtin_amdgcn_global_load_lds((const unsigned*)(Kg + (size_t)blk * 2048 + f * 512), (LAS unsigned*)(slot + f * 1024), 16, 0, 0);
#pragma unroll
    for (int f = 0; f < 4; ++f) __builtin_amdgcn_global_load_lds((const unsigned*)(Vg + (size_t)blk * 2048 + f * 512), (LAS unsigned*)(slot + 4096 + f * 1024), 16, 0, 0);
}
template <bool ISB>
DI void attn_block(const LAS unsigned char* slot, const bf16x8 (&qf)[2][4], f32x16 (&o)[2][2], float (&mrun)[2], float (&lrun)[2], int kb, int r, int hh, int lane, const LAS float* biasR, float bconst, int qoff, int nq) {
    bf16x8 kf[4], vf[2][2];
#pragma unroll
    for (int ds = 0; ds < 4; ++ds) kf[ds] = *(const LAS bf16x8*)(slot + ds * 1024 + lane * 16);
#pragma unroll
    for (int db = 0; db < 2; ++db)
#pragma unroll
        for (int t = 0; t < 2; ++t) vf[db][t] = *(const LAS bf16x8*)(slot + 4096 + (db * 2 + t) * 1024 + lane * 16);
#pragma unroll
    for (int qb = 0; qb < 2; ++qb) {
        if (qb >= nq) continue;
        f32x16 s;
#pragma unroll
        for (int i = 0; i < 16; ++i) s[i] = 0.f;
#pragma unroll
        for (int ds = 0; ds < 4; ++ds) s = MFMA32(kf[ds], qf[qb][ds], s);
        float cadd = 0.f;
        if (!ISB) {
            if (kb >= 12) {
                const LAS float* bp = biasR + (191 - (512 + qoff + 32 * qb + r - 32 * kb - 4 * hh));
#pragma unroll
                for (int i = 0; i < 16; ++i) s[i] += bp[8 * (i >> 2) + (i & 3)];
            } else cadd = bconst;
        }
        float mx = fmaxf(fmaxf(s[0], s[1]), s[2]);
#pragma unroll
        for (int i = 3; i < 15; i += 2) mx = fmaxf(fmaxf(mx, s[i]), s[i + 1]);
        mx = fmaxf(mx, s[15]);
        mx = fmaxf(mx, __shfl_xor(mx, 32)) + cadd;
        if (__any(mx > mrun[qb] + 8.f)) {
            const float mnew = fmaxf(mrun[qb], mx), alpha = __builtin_amdgcn_exp2f(mrun[qb] - mnew);
            mrun[qb] = mnew; lrun[qb] *= alpha;
#pragma unroll
            for (int i = 0; i < 16; ++i) { o[qb][0][i] *= alpha; o[qb][1][i] *= alpha; }
        }
        const float c = cadd - mrun[qb];
        float psum = 0.f;
#pragma unroll
        for (int i = 0; i < 16; ++i) { s[i] = __builtin_amdgcn_exp2f(s[i] + c); psum += s[i]; }
        lrun[qb] += psum;
        bf16x8 pf[2];
#pragma unroll
        for (int t = 0; t < 2; ++t) { u32x4 p; p.x = pk2(s[8 * t], s[8 * t + 1]); p.y = pk2(s[8 * t + 2], s[8 * t + 3]); p.z = pk2(s[8 * t + 4], s[8 * t + 5]); p.w = pk2(s[8 * t + 6], s[8 * t + 7]);
            pf[t] = __builtin_bit_cast(bf16x8, p); }
#pragma unroll
        for (int db = 0; db < 2; ++db)
#pragma unroll
            for (int t = 0; t < 2; ++t) o[qb][db] = MFMA32(vf[db][t], pf[t], o[qb][db]);
    }
}
template <bool ISB>
DI void attn_unit(int u, int hq, int qoff, int nq, const bf16_t* Qb, const bf16_t* Kb, const bf16_t* Vtb, bf16_t* O, const float* sinks, const LAS float* biasL, LAS unsigned char* ring, int lane) {
    constexpr int NCH = ISB ? 3 : 9, KROWS = ISB ? KB_ROWS : KA_ROWS;
    const int r = lane & 31, hh = lane >> 5;
    const int hk = ISB ? (hq >> 2) : hq;
    int kbase, j0;
    if (u < 256) { kbase = 64 * (u - (NCH - 1)); j0 = (NCH - 1) - u; if (j0 < 0) j0 = 0; } else { kbase = SEQ + (u - 256) * (64 * NCH); j0 = 0; }
    const bf16_t* Qp = Qb + ((size_t)hq * MTOK + 64 * u + qoff) * 64;
    const bf16_t* Kp = Kb + (size_t)hk * KROWS * 64 + 8 * lane;
    const bf16_t* Vp = Vtb + (size_t)hk * KROWS * 64 + 8 * lane;
    const int kb0 = 2 * j0, kbN = 2 * NCH, blk0 = (kbase >> 5) + kb0, nb = kbN - kb0;
    asm volatile("s_waitcnt vmcnt(0) lgkmcnt(0)" ::: "memory");
    kv_dma(Kp, Vp, blk0, ring);
    kv_dma(Kp, Vp, blk0 + 1, ring + 8192);
    bf16x8 qf[2][4];
#pragma unroll
    for (int qb = 0; qb < 2; ++qb)
#pragma unroll
        for (int ds = 0; ds < 4; ++ds) qf[qb][ds] = *(const bf16x8*)(Qp + (qb < nq ? 32 * qb + r : r) * 64 + 16 * ds + 8 * hh);
    f32x16 o[2][2];
#pragma unroll
    for (int a = 0; a < 2; ++a)
#pragma unroll
        for (int b = 0; b < 2; ++b)
#pragma unroll
            for (int i = 0; i < 16; ++i) o[a][b][i] = 0.f;
    float mrun[2], lrun[2];
#pragma unroll
    for (int a = 0; a < 2; ++a) {
        if (ISB) { mrun[a] = sinks[hq] * LOG2E; lrun[a] = hh ? 0.f : 1.f; }
        else { mrun[a] = -1e30f; lrun[a] = 0.f; } }
    const LAS float* biasR = biasL + hq * 256;
    const float bconst = ISB ? 0.f : biasR[0];
    asm volatile("s_waitcnt vmcnt(0)" ::: "memory");
    for (int ib = 0; ib < nb; ++ib) {
        LAS unsigned char* slot = ring + (ib & 1) * 8192;
        if (ib >= 2) { if (ib + 1 < nb) asm volatile("s_waitcnt vmcnt(8)" ::: "memory"); else asm volatile("s_waitcnt vmcnt(0)" ::: "memory"); }
        attn_block<ISB>(slot, qf, o, mrun, lrun, kb0 + ib, r, hh, lane, biasR, bconst, qoff, nq);
        if (ib + 2 < nb) { asm volatile("s_waitcnt lgkmcnt(0)" ::: "memory"); __builtin_amdgcn_sched_barrier(0); kv_dma(Kp, Vp, blk0 + ib + 2, slot); }
    }
#pragma unroll
    for (int qb = 0; qb < 2; ++qb) {
        if (qb >= nq) continue;
        const float l = lrun[qb] + __shfl_xor(lrun[qb], 32), inv = 1.f / l;
        bf16_t* op = O + (size_t)(64 * u + qoff + 32 * qb + r) * DM + (ISB ? 512 : 0) + hq * 64 + 4 * hh;
#pragma unroll
        for (int db = 0; db < 2; ++db)
#pragma unroll
            for (int i4 = 0; i4 < 4; ++i4) { f32x4 v = {o[qb][db][4 * i4] * inv, o[qb][db][4 * i4 + 1] * inv, o[qb][db][4 * i4 + 2] * inv, o[qb][db][4 * i4 + 3] * inv};
                *(u32x2*)(op + 32 * db + 8 * i4) = pk4(v); }
    }
}

DI float wave_sum(float v) {
#pragma unroll
    for (int o = 1; o < 64; o <<= 1) v += __shfl_xor(v, o);
    return v;
}
DI void transpose_item(const float* W, int ldw, int k0, int n, bf16_t* WT, int Kd, int dst_row, const float* kscale) {
    float v[64];
#pragma unroll
    for (int i = 0; i < 64; ++i) v[i] = W[(size_t)(k0 + i) * ldw + n];
    if (kscale) {
#pragma unroll
        for (int i = 0; i < 64; ++i) v[i] *= kscale[k0 + i];
    }
    bf16_t* d = WT + (size_t)dst_row * Kd + k0;
#pragma unroll
    for (int c = 0; c < 8; ++c) { u32x4 o; o.x = pk2(v[8 * c], v[8 * c + 1]); o.y = pk2(v[8 * c + 2], v[8 * c + 3]); o.z = pk2(v[8 * c + 4], v[8 * c + 5]); o.w = pk2(v[8 * c + 6], v[8 * c + 7]);
        *(u32x4*)(d + 8 * c) = o; }
}
DI void vt_item(const float* src, int past, int nh, int band, int krows, bf16_t* VT, int item, int lane) {
    const int nrb = past / 32, rb = item % nrb, h = (item / nrb) % nh, b = item / (nrb * nh), r0 = rb * 32;
    float v[32];
#pragma unroll
    for (int i = 0; i < 32; ++i) v[i] = src[(((size_t)b * past + r0 + i) * nh + h) * 64 + lane];
    const int krow = SEQ + b * band + r0;
#pragma unroll
    for (int t = 0; t < 2; ++t)
#pragma unroll
        for (int hh = 0; hh < 2; ++hh) { const int k0 = 16 * t + 4 * hh; u32x4 o; o.x = pk2(v[k0], v[k0 + 1]); o.y = pk2(v[k0 + 2], v[k0 + 3]); o.z = pk2(v[k0 + 8], v[k0 + 9]); o.w = pk2(v[k0 + 10], v[k0 + 11]);
            *(u32x4*)(VT + vf_off(h, krows >> 5, krow + k0, lane)) = o; }
}

typedef const __attribute__((address_space(4))) Args* KArgs;
DI void prologue(KArgs ap, int gw, int NGW, int lane) {
    unsigned char* ws = ap->ws;
    const float *xp = ap->in[0], *xs = ap->in[1], *g_attn = ap->in[7], *w_in = ap->in[8];
    { unsigned* z = (unsigned*)(ws + WS_X1B); for (int i = gw * 64 + lane; i < 2 * DM / 2; i += NGW * 64) z[i] = 0u;
      if (gw == 1) { float* gd = (float*)(ws + WS_GAINS); gd[lane] = ap->in[9][lane]; gd[64 + lane] = ap->in[10][lane]; gd[128 + lane] = ap->in[12][lane]; gd[192 + lane] = ap->in[13][lane]; } }
    { float* rt = (float*)(ws + WS_ROPE);
      for (int e = gw * 64 + lane; e < SEQ * 32; e += NGW * 64) { const int pos = e >> 5, i = e & 31;
          const float inv = exp2f(-(float)i * (13.287712379549449f / 32.f));
          double rev = (double)pos * (double)inv * 0.15915494309189535; rev -= __builtin_rint(rev);
          const float fr_ = (float)rev; rt[2 * e] = __builtin_amdgcn_cosf(fr_); rt[2 * e + 1] = __builtin_amdgcn_sinf(fr_); } }
    for (int it = gw; it < 16 * 36; it += NGW) { const int kb = it / 36, hh = it % 36, bj = lane >> 5, x = lane & 31;
        transpose_item(w_in, NIN, 64 * kb, 64 * hh + lane, (bf16_t*)(ws + WS_WIN), DM, 256 * (hh >> 2) + 128 * bj + 32 * (hh & 3) + x, nullptr); }
    {
        f32x4 gg[4];
#pragma unroll
        for (int j = 0; j < 4; ++j) gg[j] = *((const f32x4*)g_attn + lane + 64 * j);
        bf16_t* XN = (bf16_t*)(ws + WS_XN);
        for (int m = gw; m < MTOK; m += NGW) {
            const f32x4* xr = (const f32x4*)(m < SEQ ? xp + (size_t)m * DM : xs + (size_t)(m - SEQ) * DM) + lane;
            f32x4 v[4]; float s = 0.f;
#pragma unroll
            for (int j = 0; j < 4; ++j) { v[j] = xr[64 * j]; s += (v[j][0] * v[j][0] + v[j][1] * v[j][1]) + (v[j][2] * v[j][2] + v[j][3] * v[j][3]); }
            const float rstd = rsqrtf(wave_sum(s) * (1.f / DM) + EPS);
            u32x2* o8 = (u32x2*)(XN + (size_t)m * DM) + lane;
#pragma unroll
            for (int j = 0; j < 4; ++j) o8[64 * j] = pk4(v[j] * rstd * gg[j]);
        }
    }
}
DI void kc_item(const float* src, int past, int nh, int band, int krows, bf16_t* KF, int item, int lane) {
    const int nrb = past / 32, h = item % nh, rb = (item / nh) % nrb, b = item / (nh * nrb), r = lane & 31, hh = lane >> 5;
    const float* sp = src + (((size_t)b * past + rb * 32 + r) * nh + h) * 64 + 8 * hh;
    bf16_t* d = KF + (((size_t)h * (krows >> 5) + ((SEQ + b * band) >> 5) + rb) * 4 * 64 + lane) * 8;
#pragma unroll
    for (int ds = 0; ds < 4; ++ds) { const f32x4 v0 = *(const f32x4*)(sp + 16 * ds), v1 = *(const f32x4*)(sp + 16 * ds + 4);
        u32x4 o; o.x = pk2(v0[0], v0[1]); o.y = pk2(v0[2], v0[3]); o.z = pk2(v1[0], v1[1]); o.w = pk2(v1[2], v1[3]);
        *(u32x4*)(d + ds * 512) = o; }
}
DI void prologue_b(KArgs ap, int gw, int NGW, int lane) {
    unsigned char* ws = ap->ws;
    const float *cak = ap->in[2], *cav = ap->in[3], *cbk = ap->in[4], *cbv = ap->in[5];
    for (int it = gw; it < NSTREAM * 16 * 8; it += NGW) kc_item(cak, 512, 8, 576, KA_ROWS, (bf16_t*)(ws + WS_KA), it, lane);
    for (int it = gw; it < NSTREAM * 4 * 2; it += NGW) kc_item(cbk, 128, 2, 192, KB_ROWS, (bf16_t*)(ws + WS_KB), it, lane);
    for (int it = gw; it < NSTREAM * 8 * 16; it += NGW) vt_item(cav, 512, 8, 576, KA_ROWS, (bf16_t*)(ws + WS_VTA), it, lane);
    for (int it = gw; it < NSTREAM * 2 * 4; it += NGW) vt_item(cbv, 128, 2, 192, KB_ROWS, (bf16_t*)(ws + WS_VTB), it, lane);
}
constexpr int WI_OUT = 16 * 16, WI_GU = 16 * 88, WI_DN = 44 * 16, WI_ALL = WI_OUT + WI_GU + WI_DN;
DI void weight_item(KArgs ap, int it, int lane) {
    unsigned char* ws = ap->ws;
    int r = it;
    if (r < WI_OUT) { const int kb = r / 16, nb = r % 16; transpose_item(ap->in[15], DM, 64 * kb, 64 * nb + lane, (bf16_t*)(ws + WS_WOUT), DM, 64 * nb + lane, nullptr); return; }
    r -= WI_OUT;
    if (r < WI_GU) { const int kb = r / 88, nb = r % 88; const int L = 64 * nb + lane; const int Lp = L < DFF ? L : L - DFF;
        transpose_item(ap->in[17], NGU, 64 * kb, L, (bf16_t*)(ws + WS_WGU), DM, 256 * (Lp >> 7) + (L < DFF ? 0 : 128) + (Lp & 127), ap->in[16]); return; }
    r -= WI_GU;
    { const int kb = r / 16, nb = r % 16; transpose_item(ap->in[20], DM, 64 * kb, 64 * nb + lane, (bf16_t*)(ws + WS_WDN), DFF, 64 * nb + lane, nullptr); }
}

#define XB_TMO      128
#define XB_XCNT(j)  (256  + 64 * (j))
#define XB_XSUB(j)  (1280 + 64 * (j))
#define XB_XGEN(j)  (2304 + 64 * (j))
#define XB_TOP      3328
#define XB_TOPGEN   3392
#define XCD_BAR_WORDS 3456
#define XB_SPIN_CAP (1u << 22)
DI unsigned xb_ld(unsigned* p)              { return __hip_atomic_load(p, __ATOMIC_RELAXED, __HIP_MEMORY_SCOPE_AGENT); }
DI unsigned xb_add(unsigned* p, unsigned v) { return __hip_atomic_fetch_add(p, v, __ATOMIC_RELAXED, __HIP_MEMORY_SCOPE_AGENT); }
DI unsigned xb_xcc_id() { return (unsigned)__builtin_amdgcn_s_getreg((3 << 11) | 20) & 0xFu; }
#define XB_SPIN(cond, bar) do { unsigned _sp = 0; while (cond) { __builtin_amdgcn_s_sleep(1); \
    if ((++_sp & 255u) == 0u) { if (xb_ld(&(bar)[XB_TMO])) break; if (_sp > XB_SPIN_CAP) { atomicAdd(&(bar)[XB_TMO], 1u); break; } } } } while (0)
struct XcdBarrier { unsigned* bar; unsigned x; volatile LAS unsigned* st; };
DI XcdBarrier xcd_barrier_post(unsigned* bar, volatile LAS unsigned* st) {
    XcdBarrier b; b.bar = bar; b.x = xb_xcc_id(); b.st = st;
    if (threadIdx.x == 0) (void)xb_add(&bar[XB_XCNT(b.x)], 1u);
    return b;
}
DI void xcd_barrier_complete(unsigned* bar, unsigned x, unsigned& nloc, unsigned& nx) {
    const unsigned G = gridDim.x * gridDim.y * gridDim.z;
    unsigned sum, cnt, mine, sp = 0u;
    for (;;) {
        sum = 0u; cnt = 0u; mine = 0u;
#pragma unroll
        for (unsigned j = 0; j < 16; ++j) { const unsigned c = xb_ld(&bar[XB_XCNT(j)]); sum += c; cnt += (c > 0u) ? 1u : 0u; mine = (j == x) ? c : mine; }
        if (sum == G) break;
        __builtin_amdgcn_s_sleep(1);
        if ((++sp & 255u) == 0u) { if (xb_ld(&bar[XB_TMO])) break; if (sp > XB_SPIN_CAP) { atomicAdd(&bar[XB_TMO], 1u); break; } }
    }
    nloc = mine > 0u ? mine : 1u; nx = cnt > 0u ? cnt : 1u;
}
DI void xcd_barrier(const XcdBarrier& b) {
    asm volatile("s_waitcnt vmcnt(0)" ::: "memory");
    __syncthreads();
    if (threadIdx.x == 0) {
        unsigned* bar = b.bar;
        __builtin_amdgcn_s_waitcnt(0);
        unsigned nloc = b.st[0], nx = b.st[1];
        if (nloc == 0u) { xcd_barrier_complete(bar, b.x, nloc, nx); b.st[0] = nloc; b.st[1] = nx; }
        const unsigned old = xb_add(&bar[XB_XSUB(b.x)], 1u);
        const unsigned gen = old / nloc;
        if (old + 1u == (gen + 1u) * nloc) {
            __builtin_amdgcn_fence(__ATOMIC_RELEASE, "agent");
            asm volatile("s_waitcnt vmcnt(0)" ::: "memory");
            const unsigned og = xb_add(&bar[XB_TOP], 1u);
            const unsigned tg = og / nx;
            if (og + 1u == (tg + 1u) * nx) xb_add(&bar[XB_TOPGEN], 1u);
            else XB_SPIN(xb_ld(&bar[XB_TOPGEN]) == tg, bar);
            __builtin_amdgcn_fence(__ATOMIC_ACQUIRE, "agent");
            xb_add(&bar[XB_XGEN(b.x)], 1u);
            asm volatile("s_waitcnt vmcnt(0)" ::: "memory");
        } else {
            XB_SPIN(xb_ld(&bar[XB_XGEN(b.x)]) == gen, bar);
            __builtin_amdgcn_fence(__ATOMIC_ACQUIRE, "agent");
            asm volatile("s_waitcnt vmcnt(0)" ::: "memory");
        }
    }
    __syncthreads();
}

__global__ void __launch_bounds__(512, 2) fwd_kernel(Args a_byval) {
    KArgs kp = (KArgs)__builtin_amdgcn_kernarg_segment_ptr();
#define KP() ({ KArgs _p = kp; asm volatile("" : "+s"(_p)); _p; })
    extern __shared__ __attribute__((aligned(16))) unsigned char lds_raw[];
    LAS unsigned char* lds = (LAS unsigned char*)lds_raw;
    const int tid = threadIdx.x, lane = tid & 63, wave = __builtin_amdgcn_readfirstlane(tid >> 6);
    const int G = gridDim.x, bx = blockIdx.x;
    const int lo = kp->ph_lo, hi = kp->ph_hi;
    unsigned char* ws = kp->ws;
#define IN(k) (lo <= (k) && (k) < hi)
#define SEAM(k) do { if (IN(k) && IN((k) + 1)) { for (int _r = 0; _r < 1 + 4 * (NREP(5) - 1); ++_r) xcd_barrier(bar); } } while (0)
    volatile LAS unsigned* MISC = (volatile LAS unsigned*)(lds + RING_BYTES + 8192);
    if (tid < 4) MISC[tid] = 0u;
    __syncthreads();
    XcdBarrier bar; bar.bar = (unsigned*)(ws + WS_BAR); bar.x = 0; bar.st = MISC;
    if (hi - lo > 1 || lo == 3) bar = xcd_barrier_post((unsigned*)(ws + WS_BAR), MISC);
    if (hi > 1000) cg::this_grid().sync();

    if (IN(0)) { for (int rep = 0; rep < NREP(0); ++rep) prologue(KP(), bx * 8 + wave, G * 8, lane); }
    SEAM(0);
    if (IN(1)) {
        pg8::Gemm g{(const bf16_t*)(ws + WS_XN), (const bf16_t*)(ws + WS_WIN), DM};
        pg8::Order<0> S; S.init(MTOK / 256, NIN / 256, G, bx, DM / 64);
        EpiQKV E{(const float*)(ws + WS_GAINS), ws, KP()->out};
        if (NREP(1) == 2) { EpiNull EN; pg8::gemm_phase<EpiNull, pg8::Order<0>, true>(lds, g, S, EN); }
        pg8::gemm_phase<EpiQKV, pg8::Order<0>, true>(lds, g, S, E);
        if (bx >= 136) prologue_b(KP(), (bx - 136) * 8 + wave, (G - 136) * 8, lane);
    }
    SEAM(1);
    if (IN(2)) {
        LAS float* biasL = (LAS float*)(lds + RING_BYTES + 8448);
        { const float* tab = KP()->in[11]; for (int i = tid; i < 8 * 256; i += 512) { const int h = i >> 8, uu = i & 255; int d = 191 - uu; d = d > 128 ? 128 : d; biasL[i] = tab[h * 257 + d + 128] * LOG2E; } }
        const float* sinks = KP()->in[14];
        __syncthreads();
        volatile LAS unsigned* wctr = (volatile LAS unsigned*)(lds + RING_BYTES + 8192 + 64);
        if (tid == 0) *wctr = 0u;
        __syncthreads();
        for (;;) {
            unsigned k = 0; if (lane == 0) k = __hip_atomic_fetch_add((LAS unsigned*)(lds + RING_BYTES + 8192 + 64), 1u, __ATOMIC_RELAXED, __HIP_MEMORY_SCOPE_WORKGROUP);
            k = __builtin_amdgcn_readfirstlane(k);
            if (k >= 19u * NREP(2)) {
                const int it = bx + 256 * (int)(k - 19u * NREP(2));
                if (it >= WI_ALL) break;
                weight_item(KP(), it, lane); continue; }
            if (k >= 19u) k -= 19u;
            if (k < 10u) { const unsigned i = (unsigned)bx + 256u * (k < 8u ? k : 8u); const int nq = k < 8u ? 2 : 1, qoff = k == 9u ? 32 : 0;
                attn_unit<false>(287 - (int)(i >> 3), (int)(i & 7), qoff, nq, (const bf16_t*)(ws + WS_QA), (const bf16_t*)(ws + WS_KA), (const bf16_t*)(ws + WS_VTA), (bf16_t*)(ws + WS_O), nullptr, biasL, lds + wave * 16384, lane); }
            else { const unsigned i = (unsigned)bx + 256u * (k - 10u); attn_unit<true>(287 - (int)(i >> 3), (int)(i & 7), 0, 2, (const bf16_t*)(ws + WS_QB), (const bf16_t*)(ws + WS_KB), (const bf16_t*)(ws + WS_VTB), (bf16_t*)(ws + WS_O), sinks, biasL, lds + wave * 16384, lane); }
        }
        __syncthreads();
    }
    SEAM(2);
    if (IN(3)) {
        const int v = (bx & 7) * 32 + (bx >> 3), x = bx & 7, j = bx >> 3;
#pragma unroll 1
        for (int step = 0; step < 6; ++step) {
            int kind, rs, rstr = 32, rc;
            if (step == 0) { kind = 3; rs = v; rc = 1; }
            else if (step == 1) { kind = 3; rs = 256 + 4 * x + j; rc = j < 4 ? 1 : 0; }
            else if (step == 2) { kind = 4; if (j < 4) { rs = 92 * x + 28 + j; rc = 2; } else { rs = 92 * x + j - 4; rc = 3; } }
            else if (step == 3) { kind = 5; rs = 4 * x + j; rc = j < 4 ? 1 : 0; }
            else if (step == 4) { kind = 4; const int base = 736 + (x < 6 ? 109 * x : 654 + 108 * (x - 6)), r = (x < 6 ? 21 : 20);
                if (j < 4) { rs = base + j; rc = 1; } else { const int jj = j - 4; rs = base + 4 + jj; rstr = 28; rc = 3 + (jj < r ? 1 : 0); } }
            else { kind = 5; rs = 32 + v; rc = 1; }
            if (kind == 3) {
                pg8::Gemm g{(const bf16_t*)(ws + WS_O), (const bf16_t*)(ws + WS_WOUT), DM};
                pg8::RangeOrder<3> S{rs, rstr, rc};
                KArgs q = KP(); EpiOut E{q->in[0], q->in[1], q->out, (bf16_t*)(ws + WS_X1B), (float*)(ws + WS_SUMSQ)};
                if (NREP(8) == 2) { EpiNull EN; pg8::gemm_phase<EpiNull, pg8::RangeOrder<3>, true>(lds, g, S, EN); }
                pg8::gemm_phase<EpiOut, pg8::RangeOrder<3>, true>(lds, g, S, E);
            } else if (kind == 4) {
                pg8::Gemm g{(const bf16_t*)(ws + WS_X1B), (const bf16_t*)(ws + WS_WGU), DM};
                pg8::RangeOrder<4> S{rs, rstr, rc};
                KArgs q = KP(); EpiGU E{(const float*)(ws + WS_SUMSQ), q->in[18], q->in[19], q->in[6], (bf16_t*)(ws + WS_Y), q->out};
#pragma nounroll
                for (int rep = 0; rep < NREP(3); ++rep) pg8::gemm_phase<EpiGU, pg8::RangeOrder<4>, true>(lds, g, S, E);
            } else {
                pg8::Gemm g{(const bf16_t*)(ws + WS_Y), (const bf16_t*)(ws + WS_WDN), DFF};
                pg8::RangeOrder<5> S{rs, rstr, rc};
                EpiDown E{KP()->out, (const bf16_t*)(ws + WS_X1B)};
                if (NREP(9) == 2) { EpiNull EN; pg8::gemm_phase<EpiNull, pg8::RangeOrder<5>, true>(lds, g, S, EN); }
                pg8::gemm_phase<EpiDown, pg8::RangeOrder<5>, true>(lds, g, S, E);
            }
            if (step == 0 || step == 2 || step == 4) xcd_barrier(bar);
        }
    }
#undef IN
#undef SEAM
}

extern "C" void kernel_launch(void* const* d_in, const int* in_sizes, int n_in, void* d_out, int out_size, void* d_ws, size_t ws_size, hipStream_t stream) {
    static int grid = 0;
    if (grid == 0) {
        int dev = 0, cus = 0, per_cu = 0;
        hipGetDevice(&dev);
        hipDeviceGetAttribute(&cus, hipDeviceAttributeMultiprocessorCount, dev);
        if (hipFuncSetAttribute((const void*)fwd_kernel, hipFuncAttributeMaxDynamicSharedMemorySize, LDS_BYTES) != hipSuccess) { fprintf(stderr, "hipFuncSetAttribute failed\n"); grid = -1; return; }
        if (hipOccupancyMaxActiveBlocksPerMultiprocessor(&per_cu, (const void*)fwd_kernel, 512, LDS_BYTES) != hipSuccess || per_cu < 1) { fprintf(stderr, "occupancy query: %d\n", per_cu); per_cu = 1; }
        (void)hipGetLastError();
        grid = 256;
        if (cus != 256) fprintf(stderr, "note: device reports %d CUs; this kernel is laid out for 256\n", cus);
        if (n_in != 21 || ws_size < 256 * MiB) { fprintf(stderr, "unexpected n_in %d / ws %zu\n", n_in, ws_size); grid = -1; return; }
    }
    if (grid < 0) return;
    if (hipMemsetAsync((char*)d_ws + WS_CTL, 0, CTL_ZERO_BYTES, stream) != hipSuccess) { fprintf(stderr, "memset failed\n"); return; }
    Args a{};
    for (int i = 0; i < 21; ++i) a.in[i] = (const float*)d_in[i];
    a.out = (float*)d_out; a.ws = (unsigned char*)d_ws;
#if N_LAUNCH_MODE == 1
    a.ph_lo = 0; a.ph_hi = 4;
    void* args[] = {&a};
    hipError_t e = hipLaunchCooperativeKernel((const void*)fwd_kernel, dim3(grid), dim3(512), args, LDS_BYTES, stream);
    if (e != hipSuccess) fprintf(stderr, "cooperative launch failed: %s (grid %d)\n", hipGetErrorString(e), grid);
#else
    for (int p = 0; p < 4; ++p) { a.ph_lo = p; a.ph_hi = p + 1; hipLaunchKernelGGL(fwd_kernel, dim3(grid), dim3(512), LDS_BYTES, stream, a); }
#endif
}
```

```cpp
#include <hip/hip_runtime.h>
#include <hip/hip_cooperative_groups.h>
#include <cstdio>
#include <cstdint>
namespace cg = cooperative_groups;

#ifndef N_LAUNCH_MODE
#define N_LAUNCH_MODE 1
#endif

#ifndef REP
#define REP 0
#endif
#define NREP(k) ((((REP) >> (k)) & 1) + 1)
#ifndef PROBE_EPI
#define PROBE_EPI 1
#endif
#define LAS __attribute__((address_space(3)))
#define DI __device__ __forceinline__
typedef unsigned short bf16_t;
typedef short bf16x8 __attribute__((ext_vector_type(8)));
typedef short s16x4 __attribute__((ext_vector_type(4)));
typedef float f32x4 __attribute__((ext_vector_type(4)));
typedef float f32x16 __attribute__((ext_vector_type(16)));
typedef unsigned u32x4 __attribute__((ext_vector_type(4)));
typedef unsigned u32x2 __attribute__((ext_vector_type(2)));

constexpr int DM = 1024, SEQ = 16384, NSTREAM = 32, DSEQ = 64, MTOK = SEQ + NSTREAM * DSEQ;
constexpr int NIN = 2304, DFF = 2816, NGU = 2 * DFF;
constexpr int KA_ROWS = SEQ + NSTREAM * 576;
constexpr int KB_ROWS = SEQ + NSTREAM * 192;
constexpr int X1B_PROMPT_ROWS = 16512;
constexpr int GU_PT = 65;
constexpr float EPS = 1e-6f, LOG2E = 1.4426950408889634f;
constexpr float QSCALE = 0.125f * LOG2E;
constexpr size_t OFF_AKP = 18874368, OFF_AVP = 19136512, OFF_BKP = 19398656, OFF_BVP = 19415040, OFF_CVP = 19431424;
constexpr size_t OFF_AKS = 19437056, OFF_AVS = 20485632, OFF_BKS = 21534208, OFF_BVS = 21796352, OFF_CVS = 22058496;
constexpr size_t MiB = 1u << 20;
constexpr size_t WS_CTL = 0, WS_GAINS = 4096, WS_BAR = 16384, WS_SUMSQ = 65536, CTL_ZERO_BYTES = 160 * 1024;
constexpr size_t WS_WIN = 1 * MiB, WS_WOUT = 6 * MiB, WS_WGU = 8 * MiB, WS_WDN = 19 * MiB;
constexpr size_t WS_X1B = 25 * MiB, WS_O = 62 * MiB, WS_VTA = 98 * MiB, WS_KB = 132 * MiB, WS_VTB = 138 * MiB;
constexpr size_t WS_XN = 144 * MiB, WS_QA = 180 * MiB, WS_QB = 198 * MiB, WS_KA = 216 * MiB;
constexpr size_t WS_ROPE = 250 * MiB;
constexpr size_t WS_Y = 144 * MiB;
constexpr int LDS_BYTES = 155648, RING_BYTES = 131072;

struct Args { const float* in[21]; float* out; unsigned char* ws; int ph_lo, ph_hi; };

DI unsigned pk2(float lo, float hi) {
    typedef float f2 __attribute__((ext_vector_type(2))); typedef __bf16 b2 __attribute__((ext_vector_type(2)));
    f2 v = {lo, hi}; b2 b = __builtin_convertvector(v, b2); return __builtin_bit_cast(unsigned, b);
}
DI size_t kf_off(int h, int nblk, int krow, int d) { return ((((size_t)h * nblk + (krow >> 5)) * 4 + (d >> 4)) * 64 + ((d >> 3) & 1) * 32 + (krow & 31)) * 8 + (d & 7); }
DI size_t vf_off(int h, int nblk, int krow, int d) { const int kk = krow & 31; return (((((size_t)h * nblk + (krow >> 5)) * 2 + (d >> 5)) * 2 + (kk >> 4)) * 64 + ((kk >> 2) & 1) * 32 + (d & 31)) * 8 + 4 * ((kk >> 3) & 1) + (kk & 3); }
DI u32x2 pk4(f32x4 v) { u32x2 r; r.x = pk2(v[0], v[1]); r.y = pk2(v[2], v[3]); return r; }

namespace pg8 {
constexpr int BM = 256, BK = 64, HALF = 128, HTB = HALF * BK * 2, NXCD = 8, WGM = 8;
DI int lds_byte(int r, int c) { const int st = (r >> 4) * 2 + (c >> 5), rr = r & 15, cc = c & 31, ob = rr * 64 + cc * 2; return st * 1024 + (ob ^ (((ob >> 9) & 1) << 5)); }
DI void stage_rc(int b, int& R, int& C) { const int st = b / 1024, sb = b % 1024, swz = sb ^ (((sb >> 9) & 1) << 5); R = (st >> 1) * 16 + swz / 64; C = (st & 1) * 32 + (swz % 64) / 2; }

struct Unit { int pm, pn, kt0, nkt; };
struct Gemm { const bf16_t* A; const bf16_t* Bt; int K; };

template <int GU> struct Order {
    int nM, nN, nwg, G, c, nkt;
    DI void init(int nM_, int nN_, int G_, int c_, int nkt_) { nM = nM_; nN = nN_; nwg = nM * nN; G = G_; c = c_; nkt = nkt_; }
    DI bool next(int i, Unit& u) const {
        const long L = (long)i * G + c; if (L >= nwg) return false;
        u.kt0 = 0; u.nkt = nkt;
        int wgid = (int)L; { const int q = nwg / NXCD, r = nwg % NXCD, xcd = wgid % NXCD, off = wgid / NXCD; wgid = (xcd < r ? xcd * (q + 1) : r * (q + 1) + (xcd - r) * q) + off; }
        const int nig = WGM * nN, gid = wgid / nig, fm = gid * WGM, gsz = (nM - fm) < WGM ? (nM - fm) : WGM;
        u.pm = fm + ((wgid % nig) % gsz); u.pn = (wgid % nig) / gsz; return true;
    }
    DI size_t a_row(int pm) const { return GU ? (size_t)(pm < GU_PT ? 254 * pm : X1B_PROMPT_ROWS + 256 * (pm - GU_PT)) : (size_t)pm * 256; }
};

template <int KIND> struct RangeOrder {
    int s, stride, cnt;
    DI bool next(int i, Unit& u) const {
        if (i >= cnt) return false;
        const int idx = s + i * stride;
        if (KIND == 4) { const int g = idx / 176, w = idx - 176 * g, gsz = (73 - 8 * g) < 8 ? (73 - 8 * g) : 8;
            u.pm = 8 * g + w % gsz; u.pn = w / gsz; u.kt0 = 0; u.nkt = 16; }
        else { u.pm = idx >> 2; u.pn = idx & 3; u.kt0 = 0; u.nkt = KIND == 5 ? 44 : 16; }
        return true;
    }
    DI size_t a_row(int pm) const { return KIND == 4 ? (size_t)(pm < GU_PT ? 254 * pm : X1B_PROMPT_ROWS + 256 * (pm - GU_PT)) : (size_t)pm * 256; }
};
struct OrderSK {
    static constexpr int NP = 22, NU = 288;
    int s, e;
    DI void init(int G, int c) { const int v = (G % 8 == 0) ? (c % 8) * (G / 8) + c / 8 : c; s = (int)((long)v * (NU * NP) / G); e = (int)((long)(v + 1) * (NU * NP) / G); }
    DI bool next(int i, Unit& u) const {
        int p = s;
        for (int k = 0; k < i; ++k) p = (p / NP + 1) * NP;
        if (p >= e) return false;
        const int unit = p / NP, pe = (unit + 1) * NP < e ? (unit + 1) * NP : e;
        u.kt0 = (p - unit * NP) * 2; u.nkt = (pe - p) * 2;
        u.pm = (unit >> 5) * 8 + (unit & 7); u.pn = (unit & 31) >> 3; return true;
    }
    DI size_t a_row(int pm) const { return (size_t)pm * 256; }
};

template <class Epi, class Sched, bool ALIGN_EPI>
DI void gemm_phase(LAS unsigned char* lds, const Gemm g, const Sched& S, const Epi& E) {
    const int tid = threadIdx.x, wid = __builtin_amdgcn_readfirstlane(tid >> 6), lane = tid & 63, wr = wid >> 2, wc = wid & 3, fr = lane & 15, fq = lane >> 4;
    const int K = g.K;
    unsigned voffA[2];
#pragma unroll
    for (int i = 0; i < 2; ++i) { int R, C; stage_rc(tid * 16 + i * 8192, R, C); voffA[i] = (unsigned)(R * K + C) * 2u; }
    const size_t kstep = (size_t)(BK * 2);
    const size_t hstep = (size_t)HALF * K * 2;
    const size_t rowb = (size_t)K * 2;
    const unsigned ldsw = (unsigned)wid * 1024u;
    const int aoff = lds_byte(wr * 64 + fr, fq * 8), boff = lds_byte(wc * 32 + fr, fq * 8);
#define PG8_SA(b, h) (((b) * 2 + (h)) * HTB)
#define PG8_SB(b, h) ((4 + (b) * 2 + (h)) * HTB)
#define PG8_STAGE(bufoff, gbase, voff) do { _Pragma("unroll") for (int _i = 0; _i < 2; ++_i) \
        __builtin_amdgcn_global_load_lds((const unsigned*)((const char*)(gbase) + (voff)[_i]), (LAS unsigned*)(lds + (bufoff) + ldsw + _i * 8192), 16, 0, 0); } while (0)
#define PG8_LDA(dst, b, h) do { _Pragma("unroll") for (int m = 0; m < 4; ++m) _Pragma("unroll") for (int k = 0; k < 2; ++k) dst[m][k] = *(const LAS bf16x8*)(lds + PG8_SA(b, h) + aoff + m * 2048 + k * 1024); } while (0)
#define PG8_LDB(dst, b, h) do { _Pragma("unroll") for (int n = 0; n < 2; ++n) _Pragma("unroll") for (int k = 0; k < 2; ++k) dst[n][k] = *(const LAS bf16x8*)(lds + PG8_SB(b, h) + boff + n * 2048 + k * 1024); } while (0)
#define PG8_MMA(ai, bj, At, Bt) do { __builtin_amdgcn_s_setprio(1); _Pragma("unroll") for (int m = 0; m < 4; ++m) _Pragma("unroll") for (int n = 0; n < 2; ++n) _Pragma("unroll") for (int k = 0; k < 2; ++k) \
        acc[ai][bj][m][n] = __builtin_amdgcn_mfma_f32_16x16x32_bf16(Bt[n][k], At[m][k], acc[ai][bj][m][n], 0, 0, 0); __builtin_amdgcn_s_setprio(0); } while (0)
#define PG8_WAIT_V(n) asm volatile("s_waitcnt vmcnt(" #n ")" ::: "memory")
#define PG8_WAIT_L(n) asm volatile("s_waitcnt lgkmcnt(" #n ")" ::: "memory")
#define PG8_BAR __builtin_amdgcn_s_barrier()
#define PG8_SCHED __builtin_amdgcn_sched_barrier(0)
    Unit cur, nxt; int ui = 0;
    if (!S.next(0, cur)) return;
    f32x4 acc[2][2][4][2];
#pragma unroll
    for (int a = 0; a < 2; ++a)
#pragma unroll
        for (int b = 0; b < 2; ++b)
#pragma unroll
            for (int m = 0; m < 4; ++m)
#pragma unroll
                for (int n = 0; n < 2; ++n) acc[a][b][m][n] = (f32x4){0.f, 0.f, 0.f, 0.f};
    bf16x8 At[4][2], B0[2][2], B1[2][2];
    const char* cA = (const char*)g.A + S.a_row(cur.pm) * rowb + (size_t)cur.kt0 * kstep; const char* cB = (const char*)g.Bt + (size_t)cur.pn * 2 * hstep + (size_t)cur.kt0 * kstep;
    PG8_STAGE(PG8_SB(0, 0), cB, voffA); PG8_STAGE(PG8_SB(0, 1), cB + hstep, voffA); PG8_STAGE(PG8_SA(0, 0), cA, voffA); PG8_STAGE(PG8_SA(0, 1), cA + hstep, voffA);
    if (wr == 1) PG8_BAR;
    PG8_WAIT_V(2); PG8_BAR;
    PG8_STAGE(PG8_SB(1, 0), cB + kstep, voffA); PG8_STAGE(PG8_SA(1, 0), cA + kstep, voffA); PG8_STAGE(PG8_SB(1, 1), cB + hstep + kstep, voffA);
    PG8_WAIT_V(6); PG8_BAR;
    for (;;) {
        const bool has_next = S.next(ui + 1, nxt);
        const char* nA = has_next ? (const char*)g.A + S.a_row(nxt.pm) * rowb + (size_t)nxt.kt0 * kstep : cA; const char* nB = has_next ? (const char*)g.Bt + (size_t)nxt.pn * 2 * hstep + (size_t)nxt.kt0 * kstep : cB;
        const int nt = cur.nkt;
        for (int t = 0; t < nt; t += 2) {
            const bool last = (t == nt - 2);
            const char* a1 = cA + (size_t)(t + 1) * kstep;
            const char* a2 = last ? nA : cA + (size_t)(t + 2) * kstep; const char* b2 = last ? nB : cB + (size_t)(t + 2) * kstep;
            const char* a3 = a2 + kstep; const char* b3 = b2 + kstep;
            PG8_LDB(B0, 0, 0); PG8_LDB(B1, 0, 1); PG8_SCHED; PG8_LDA(At, 0, 0); PG8_STAGE(PG8_SA(1, 1), a1 + hstep, voffA);
            PG8_WAIT_V(8); PG8_WAIT_L(0); PG8_BAR; PG8_MMA(0, 0, At, B0); PG8_MMA(0, 1, At, B1); PG8_BAR; PG8_SCHED;
            PG8_LDA(At, 0, 1); PG8_STAGE(PG8_SB(0, 0), b2, voffA); PG8_STAGE(PG8_SB(0, 1), b2 + hstep, voffA); PG8_STAGE(PG8_SA(0, 0), a2, voffA);
            PG8_WAIT_V(8); PG8_WAIT_L(0); PG8_BAR; PG8_MMA(1, 0, At, B0); PG8_MMA(1, 1, At, B1); PG8_BAR; PG8_SCHED;
            PG8_LDB(B0, 1, 0); PG8_LDB(B1, 1, 1); PG8_SCHED; PG8_LDA(At, 1, 0); PG8_STAGE(PG8_SA(0, 1), a2 + hstep, voffA);
            PG8_WAIT_V(8); PG8_WAIT_L(0); PG8_BAR; PG8_MMA(0, 0, At, B0); PG8_MMA(0, 1, At, B1); PG8_BAR; PG8_SCHED;
            PG8_LDA(At, 1, 1); PG8_STAGE(PG8_SB(1, 0), b3, voffA); PG8_STAGE(PG8_SB(1, 1), b3 + hstep, voffA); PG8_STAGE(PG8_SA(1, 0), a3, voffA);
            PG8_WAIT_V(8); PG8_WAIT_L(0); PG8_BAR; PG8_MMA(1, 0, At, B0); PG8_MMA(1, 1, At, B1); PG8_BAR; PG8_SCHED;
        }
        if constexpr (ALIGN_EPI) { if (wr == 0) PG8_BAR; }
        E(acc, cur, wr, wc, fr, fq, lds + RING_BYTES);
        if constexpr (NREP(7) == 2 && Epi::PROBE2) E(acc, cur, wr, wc, fr, fq, lds + RING_BYTES);
        if (!has_next) break;
#pragma unroll
        for (int a = 0; a < 2; ++a)
#pragma unroll
            for (int b = 0; b < 2; ++b)
#pragma unroll
                for (int m = 0; m < 4; ++m)
#pragma unroll
                    for (int n = 0; n < 2; ++n) acc[a][b][m][n] = (f32x4){0.f, 0.f, 0.f, 0.f};
        cur = nxt; cA = nA; cB = nB; ++ui;
        if constexpr (ALIGN_EPI) { if (wr == 1) PG8_BAR; }
    }
    PG8_WAIT_V(0);
    if constexpr (!ALIGN_EPI) { if (wr == 0) PG8_BAR; }
    PG8_BAR;
#undef PG8_SA
#undef PG8_SB
#undef PG8_STAGE
#undef PG8_LDA
#undef PG8_LDB
#undef PG8_MMA
#undef PG8_WAIT_V
#undef PG8_WAIT_L
#undef PG8_BAR
#undef PG8_SCHED
}
}
using pg8::Unit;
typedef f32x4 AccT[2][2][4][2];

struct EpiQKV {
    static constexpr bool PROBE2 = (PROBE_EPI == 1);
    const float* gains;
    unsigned char* ws; float* out;
    DI void operator()(const AccT& acc, const Unit& u, int wr, int wc, int fr, int fq, LAS unsigned char*) const {
        const int hh = u.pn * 4 + wc;
        int kind, h;
        if (hh < 8) { kind = 0; h = hh; } else if (hh < 16) { kind = 1; h = hh - 8; } else if (hh < 24) { kind = 2; h = hh - 16; }
        else if (hh < 32) { kind = 3; h = hh - 24; } else if (hh < 34) { kind = 4; h = hh - 32; } else { kind = 5; h = hh - 34; }
        const bool donorm = (kind != 2 && kind != 5), dorope = (kind == 3 || kind == 4);
        const float* gain = gains + 64 * (kind == 0 ? 0 : (kind == 1 ? 1 : (kind == 3 ? 2 : 3)));
        f32x4 gv[2][2];
#pragma unroll
        for (int bj = 0; bj < 2; ++bj)
#pragma unroll
            for (int n = 0; n < 2; ++n) gv[bj][n] = donorm ? *(const f32x4*)(gain + 32 * bj + 16 * n + 4 * fq) : (f32x4){1.f, 1.f, 1.f, 1.f};
#pragma unroll
        for (int ai = 0; ai < 2; ++ai)
#pragma unroll
            for (int m = 0; m < 4; ++m) {
                const int row = u.pm * 256 + ai * 128 + wr * 64 + m * 16 + fr;
                f32x4 v[2][2];
#pragma unroll
                for (int bj = 0; bj < 2; ++bj)
#pragma unroll
                    for (int n = 0; n < 2; ++n) v[bj][n] = acc[ai][bj][m][n];
                if (donorm) {
                    float ss = 0.f;
#pragma unroll
                    for (int bj = 0; bj < 2; ++bj)
#pragma unroll
                        for (int n = 0; n < 2; ++n) ss += (v[bj][n][0] * v[bj][n][0] + v[bj][n][1] * v[bj][n][1]) + (v[bj][n][2] * v[bj][n][2] + v[bj][n][3] * v[bj][n][3]);
                    ss += __shfl_xor(ss, 16); ss += __shfl_xor(ss, 32);
                    const float rs = rsqrtf(ss * (1.f / 64.f) + EPS);
#pragma unroll
                    for (int bj = 0; bj < 2; ++bj)
#pragma unroll
                        for (int n = 0; n < 2; ++n) v[bj][n] = v[bj][n] * rs * gv[bj][n];
                }
                if (dorope) {
                    const int pos = row < SEQ ? row : 1024 + ((row - SEQ) & 63);
                    const f32x4* rt = (const f32x4*)((const float*)(ws + WS_ROPE) + ((size_t)pos * 32 + 4 * fq) * 2);
#pragma unroll
                    for (int n = 0; n < 2; ++n) {
                        const f32x4 t0 = rt[8 * n], t1 = rt[8 * n + 1];
                        const float cs[4] = {t0[0], t0[2], t1[0], t1[2]}, sn[4] = {t0[1], t0[3], t1[1], t1[3]};
#pragma unroll
                        for (int j = 0; j < 4; ++j) { const float x1 = v[0][n][j], x2 = v[1][n][j]; v[0][n][j] = x1 * cs[j] - x2 * sn[j]; v[1][n][j] = x2 * cs[j] + x1 * sn[j]; }
                    }
                }
                if (kind == 0 || kind == 3) {
                    bf16_t* q = (bf16_t*)(ws + (kind == 0 ? WS_QA : WS_QB)) + ((size_t)h * MTOK + row) * 64 + 4 * fq;
#pragma unroll
                    for (int bj = 0; bj < 2; ++bj)
#pragma unroll
                        for (int n = 0; n < 2; ++n) *(u32x2*)(q + 32 * bj + 16 * n) = pk4(v[bj][n] * QSCALE);
                } else {
                    const bool isA = (kind == 1 || kind == 2), isK = (kind == 1 || kind == 4);
                    const int srow = row - SEQ;
                    const int band = isA ? 576 : 192, past = isA ? 512 : 128, nh = isA ? 8 : 2;
                    const int krow = row < SEQ ? row : SEQ + (srow >> 6) * band + past + (srow & 63);
                    const int krows = isA ? KA_ROWS : KB_ROWS;
                    float* op = nullptr;
                    size_t ooff = 0; bool has_o = false;
                    if (row >= SEQ) { ooff = (isA ? (isK ? OFF_AKS : OFF_AVS) : (isK ? OFF_BKS : OFF_BVS)) + ((size_t)srow * nh + h) * 64; has_o = true; }
                    else if (row >= SEQ - past) { ooff = (isA ? (isK ? OFF_AKP : OFF_AVP) : (isK ? OFF_BKP : OFF_BVP)) + ((size_t)(row - (SEQ - past)) * nh + h) * 64; has_o = true; }
                    op = out + ooff;
                    if (has_o) {
#pragma unroll
                        for (int bj = 0; bj < 2; ++bj)
#pragma unroll
                            for (int n = 0; n < 2; ++n) *(f32x4*)(op + 32 * bj + 16 * n + 4 * fq) = v[bj][n];
                    }
                    if (isK) {
                        bf16_t* kp = (bf16_t*)(ws + (isA ? WS_KA : WS_KB));
#pragma unroll
                        for (int bj = 0; bj < 2; ++bj)
#pragma unroll
                            for (int n = 0; n < 2; ++n) *(u32x2*)(kp + kf_off(h, krows >> 5, krow, 32 * bj + 16 * n + 4 * fq)) = pk4(v[bj][n]);
                    } else {
                        bf16_t* vp = (bf16_t*)(ws + (isA ? WS_VTA : WS_VTB));
#pragma unroll
                        for (int bj = 0; bj < 2; ++bj)
#pragma unroll
                            for (int n = 0; n < 2; ++n)
#pragma unroll
                                for (int j = 0; j < 4; ++j) {
                                    const float mine = v[bj][n][j], oth = __shfl_xor(mine, 1);
                                    if (!(fr & 1)) *(unsigned*)(vp + vf_off(h, krows >> 5, krow, 32 * bj + 16 * n + 4 * fq + j)) = pk2(mine, oth);
                                }
                    }
                }
            }
    }
};

struct EpiNull {
    static constexpr bool PROBE2 = false;
    DI void operator()(const AccT& acc, const Unit& u, int wr, int wc, int fr, int fq, LAS unsigned char*) const {
#pragma unroll
        for (int ai = 0; ai < 2; ++ai)
#pragma unroll
            for (int bj = 0; bj < 2; ++bj)
#pragma unroll
                for (int m = 0; m < 4; ++m)
#pragma unroll
                    for (int n = 0; n < 2; ++n) asm volatile("" :: "v"(acc[ai][bj][m][n]));
    }
};
struct EpiOut {
    static constexpr bool PROBE2 = false;
    const float *xp, *xs; float* out; bf16_t* X1B; float* sumsq;
    DI void operator()(const AccT& acc, const Unit& u, int wr, int wc, int fr, int fq, LAS unsigned char*) const {
        const int col0 = u.pn * 256 + wc * 32 + 4 * fq;
#pragma unroll
        for (int ai = 0; ai < 2; ++ai)
#pragma unroll
            for (int m = 0; m < 4; ++m) {
                const int row = u.pm * 256 + ai * 128 + wr * 64 + m * 16 + fr;
                const float* xr = (row < SEQ ? xp + (size_t)row * DM : xs + (size_t)(row - SEQ) * DM) + col0;
                bf16_t* brow = X1B + (size_t)(row < SEQ ? row + 2 : row + (X1B_PROMPT_ROWS - SEQ)) * DM + col0;
                float ss = 0.f;
#pragma unroll
                for (int bj = 0; bj < 2; ++bj)
#pragma unroll
                    for (int n = 0; n < 2; ++n) {
                        const int c = bj * 128 + n * 16;
                        const f32x4 o = *(const f32x4*)(xr + c) + acc[ai][bj][m][n];
                        *(u32x2*)(brow + c) = pk4(o);
                        ss += (o[0] * o[0] + o[1] * o[1]) + (o[2] * o[2] + o[3] * o[3]);
                    }
                ss += __shfl_xor(ss, 16); ss += __shfl_xor(ss, 32);
                if (fq == 0) unsafeAtomicAdd(sumsq + row, ss);
            }
    }
};

struct EpiGU {
    static constexpr bool PROBE2 = (PROBE_EPI == 4);
    const float *sumsq, *convw, *convb, *state; bf16_t* Y; float* out;
    DI void operator()(const AccT& acc, const Unit& u, int wr, int wc, int fr, int fq, LAS unsigned char* ldsx) const {
        LAS float* H = (LAS float*)ldsx;
        const int T = u.pm; const bool prompt = T < GU_PT; const int lane = fq * 16 + fr;
        const int tok0 = (prompt ? 254 * T - 2 : SEQ + 256 * (T - GU_PT)) + 64 * wr + fr;
        f32x4 w0[2], w1[2], w2[2], cb[2];
#pragma unroll
        for (int n = 0; n < 2; ++n) { const int f = u.pn * 128 + wc * 32 + 16 * n + 4 * fq;
            w0[n] = *(const f32x4*)(convw + f); w1[n] = *(const f32x4*)(convw + DFF + f); w2[n] = *(const f32x4*)(convw + 2 * DFF + f); cb[n] = *(const f32x4*)(convb + f); }
        float rs[2][4];
#pragma unroll
        for (int ai = 0; ai < 2; ++ai)
#pragma unroll
            for (int m = 0; m < 4; ++m) { const int tok = tok0 + 128 * ai + 16 * m; const bool ok = tok >= 0 && tok < (prompt ? SEQ : MTOK);
                rs[ai][m] = ok ? rsqrtf(sumsq[ok ? tok : 0] * (1.f / DM) + EPS) : 0.f; }
        if (prompt) {
            if (fr >= 14) {
#pragma unroll
                for (int ai = 0; ai < 2; ++ai)
#pragma unroll
                    for (int n = 0; n < 2; ++n) *(LAS f32x4*)(H + ((ai * 2 + wr) * 4 + wc) * 64 + (fr - 14) * 32 + 16 * n + 4 * fq) = acc[ai][0][3][n] * rs[ai][3];
            }
            asm volatile("s_waitcnt lgkmcnt(0)" ::: "memory"); __builtin_amdgcn_s_barrier(); asm volatile("" ::: "memory");
        }
#pragma unroll
        for (int n = 0; n < 2; ++n) {
            const int f = u.pn * 128 + wc * 32 + 16 * n + 4 * fq;
#pragma unroll
            for (int ai = 0; ai < 2; ++ai) {
                f32x4 hm1 = {0.f, 0.f, 0.f, 0.f}, hm2 = {0.f, 0.f, 0.f, 0.f};
                const int sb = 4 * (T - GU_PT) + 2 * ai + wr;
                if (prompt) {
                    if (ai | wr) { const int sai = wr ? ai : ai - 1, swr = wr ^ 1; const LAS float* hp = H + ((sai * 2 + swr) * 4 + wc) * 64 + 16 * n + 4 * fq;
                        hm2 = *(const LAS f32x4*)hp; hm1 = *(const LAS f32x4*)(hp + 32); }
                } else { hm2 = *(const f32x4*)(state + (size_t)(sb * 2) * DFF + f); hm1 = *(const f32x4*)(state + (size_t)(sb * 2 + 1) * DFF + f); }
                f32x4 p1 = hm1, p2;
#pragma unroll
                for (int j = 0; j < 4; ++j) p2[j] = fr == 1 ? hm1[j] : hm2[j];
#pragma unroll
                for (int m = 0; m < 4; ++m) {
                    const f32x4 g = acc[ai][0][m][n] * rs[ai][m];
                    f32x4 gm1, gm2;
#pragma unroll
                    for (int j = 0; j < 4; ++j) {
                        gm1[j] = __int_as_float(__builtin_amdgcn_update_dpp(__float_as_int(p1[j]), __float_as_int(g[j]), 0x111, 0xf, 0xf, false));
                        gm2[j] = __int_as_float(__builtin_amdgcn_update_dpp(__float_as_int(p2[j]), __float_as_int(g[j]), 0x112, 0xf, 0xf, false));
                        if (m < 3) {
                            p1[j] = __int_as_float(__builtin_amdgcn_update_dpp(0, __float_as_int(g[j]), 0x121, 0xf, 0xf, false));
                            p2[j] = __int_as_float(__builtin_amdgcn_update_dpp(0, __float_as_int(g[j]), 0x122, 0xf, 0xf, false)); }
                    }
                    const f32x4 cv = cb[n] + w0[n] * gm2 + w1[n] * gm1 + w2[n] * g;
                    const f32x4 up = acc[ai][1][m][n] * rs[ai][m];
                    f32x4 y;
#pragma unroll
                    for (int j = 0; j < 4; ++j) y[j] = cv[j] * __builtin_amdgcn_rcpf(1.f + __builtin_amdgcn_exp2f(-cv[j] * LOG2E)) * up[j];
                    const int tok = tok0 + 128 * ai + 16 * m;
                    const int rloc = 128 * ai + 64 * wr + 16 * m + fr;
                    const bool ok = prompt ? (rloc >= 2 && tok < SEQ) : true;
                    if (ok) *(u32x2*)(Y + (size_t)tok * DFF + f) = pk4(y);
                    if (prompt) { if (tok == SEQ - 2 || tok == SEQ - 1) *(f32x4*)(out + OFF_CVP + (size_t)(tok - (SEQ - 2)) * DFF + f) = g; }
                    else if (m == 3 && fr >= 14) *(f32x4*)(out + OFF_CVS + (size_t)(sb * 2 + (fr - 14)) * DFF + f) = g;
                }
            }
        }
    }
};

struct EpiDown {
    static constexpr bool PROBE2 = false;
    float* out; const bf16_t* X1B;
    DI void operator()(const AccT& acc, const Unit& u, int wr, int wc, int fr, int fq, LAS unsigned char*) const {
        const int col0 = u.pn * 256 + wc * 32 + 4 * fq;
#pragma unroll
        for (int ai = 0; ai < 2; ++ai)
#pragma unroll
            for (int m = 0; m < 4; ++m) {
                const int row = u.pm * 256 + ai * 128 + wr * 64 + m * 16 + fr;
                float* orow = out + (size_t)row * DM + col0;
                const bf16_t* brow = X1B + (size_t)(row < SEQ ? row + 2 : row + (X1B_PROMPT_ROWS - SEQ)) * DM + col0;
#pragma unroll
                for (int bj = 0; bj < 2; ++bj)
#pragma unroll
                    for (int n = 0; n < 2; ++n) { const int c = bj * 128 + n * 16; const u32x2 xb = *(const u32x2*)(brow + c);
                        const f32x4 xr = {__uint_as_float(xb.x << 16), __uint_as_float(xb.x & 0xffff0000u), __uint_as_float(xb.y << 16), __uint_as_float(xb.y & 0xffff0000u)};
                        *(f32x4*)(orow + c) = xr + acc[ai][bj][m][n]; }
            }
    }
};

#define MFMA32(a, b, c) __builtin_amdgcn_mfma_f32_32x32x16_bf16((a), (b), (c), 0, 0, 0)
DI void kv_dma(const bf16_t* Kg, const bf16_t* Vg, int blk, LAS unsigned char* slot) {
#pragma unroll
    for (int f = 0; f < 4; ++f) __builtin_amdgcn_global_load_lds((const unsigned*)(Kg + (size_t)blk * 2048 + f * 512), (LAS unsigned*)(slot + f * 1024), 16, 0, 0);
#pragma unroll
    for (int f = 0; f < 4; ++f) __builtin_amdgcn_global_load_lds((const unsigned*)(Vg + (size_t)blk * 2048 + f * 512), (LAS unsigned*)(slot + 4096 + f * 1024), 16, 0, 0);
}
template <bool ISB>
DI void attn_block(const LAS unsigned char* slot, const bf16x8 (&qf)[2][4], f32x16 (&o)[2][2], float (&mrun)[2], float (&lrun)[2], int kb, int r, int hh, int lane, const LAS float* biasR, float bconst, int qoff, int nq) {
    bf16x8 kf[4], vf[2][2];
#pragma unroll
    for (int ds = 0; ds < 4; ++ds) kf[ds] = *(const LAS bf16x8*)(slot + ds * 1024 + lane * 16);
#pragma unroll
    for (int db = 0; db < 2; ++db)
#pragma unroll
        for (int t = 0; t < 2; ++t) vf[db][t] = *(const LAS bf16x8*)(slot + 4096 + (db * 2 + t) * 1024 + lane * 16);
#pragma unroll
    for (int qb = 0; qb < 2; ++qb) {
        if (qb >= nq) continue;
        f32x16 s;
#pragma unroll
        for (int i = 0; i < 16; ++i) s[i] = 0.f;
#pragma unroll
        for (int ds = 0; ds < 4; ++ds) s = MFMA32(kf[ds], qf[qb][ds], s);
        float cadd = 0.f;
        if (!ISB) {
            if (kb >= 12) {
                const LAS float* bp = biasR + (191 - (512 + qoff + 32 * qb + r - 32 * kb - 4 * hh));
#pragma unroll
                for (int i = 0; i < 16; ++i) s[i] += bp[8 * (i >> 2) + (i & 3)];
            } else cadd = bconst;
        }
        float mx = fmaxf(fmaxf(s[0], s[1]), s[2]);
#pragma unroll
        for (int i = 3; i < 15; i += 2) mx = fmaxf(fmaxf(mx, s[i]), s[i + 1]);
        mx = fmaxf(mx, s[15]);
        mx = fmaxf(mx, __shfl_xor(mx, 32)) + cadd;
        if (__any(mx > mrun[qb] + 8.f)) {
            const float mnew = fmaxf(mrun[qb], mx), alpha = __builtin_amdgcn_exp2f(mrun[qb] - mnew);
            mrun[qb] = mnew; lrun[qb] *= alpha;
#pragma unroll
            for (int i = 0; i < 16; ++i) { o[qb][0][i] *= alpha; o[qb][1][i] *= alpha; }
        }
        const float c = cadd - mrun[qb];
        float psum = 0.f;
#pragma unroll
        for (int i = 0; i < 16; ++i) { s[i] = __builtin_amdgcn_exp2f(s[i] + c); psum += s[i]; }
        lrun[qb] += psum;
        bf16x8 pf[2];
#pragma unroll
        for (int t = 0; t < 2; ++t) { u32x4 p; p.x = pk2(s[8 * t], s[8 * t + 1]); p.y = pk2(s[8 * t + 2], s[8 * t + 3]); p.z = pk2(s[8 * t + 4], s[8 * t + 5]); p.w = pk2(s[8 * t + 6], s[8 * t + 7]);
            pf[t] = __builtin_bit_cast(bf16x8, p); }
#pragma unroll
        for (int db = 0; db < 2; ++db)
#pragma unroll
            for (int t = 0; t < 2; ++t) o[qb][db] = MFMA32(vf[db][t], pf[t], o[qb][db]);
    }
}
template <bool ISB>
DI void attn_unit(int u, int hq, int qoff, int nq, const bf16_t* Qb, const bf16_t* Kb, const bf16_t* Vtb, bf16_t* O, const float* sinks, const LAS float* biasL, LAS unsigned char* ring, int lane) {
    constexpr int NCH = ISB ? 3 : 9, KROWS = ISB ? KB_ROWS : KA_ROWS;
    const int r = lane & 31, hh = lane >> 5;
    const int hk = ISB ? (hq >> 2) : hq;
    int kbase, j0;
    if (u < 256) { kbase = 64 * (u - (NCH - 1)); j0 = (NCH - 1) - u; if (j0 < 0) j0 = 0; } else { kbase = SEQ + (u - 256) * (64 * NCH); j0 = 0; }
    const bf16_t* Qp = Qb + ((size_t)hq * MTOK + 64 * u + qoff) * 64;
    const bf16_t* Kp = Kb + (size_t)hk * KROWS * 64 + 8 * lane;
    const bf16_t* Vp = Vtb + (size_t)hk * KROWS * 64 + 8 * lane;
    const int kb0 = 2 * j0, kbN = 2 * NCH, blk0 = (kbase >> 5) + kb0, nb = kbN - kb0;
    asm volatile("s_waitcnt vmcnt(0) lgkmcnt(0)" ::: "memory");
    kv_dma(Kp, Vp, blk0, ring);
    kv_dma(Kp, Vp, blk0 + 1, ring + 8192);
    bf16x8 qf[2][4];
#pragma unroll
    for (int qb = 0; qb < 2; ++qb)
#pragma unroll
        for (int ds = 0; ds < 4; ++ds) qf[qb][ds] = *(const bf16x8*)(Qp + (qb < nq ? 32 * qb + r : r) * 64 + 16 * ds + 8 * hh);
    f32x16 o[2][2];
#pragma unroll
    for (int a = 0; a < 2; ++a)
#pragma unroll
        for (int b = 0; b < 2; ++b)
#pragma unroll
            for (int i = 0; i < 16; ++i) o[a][b][i] = 0.f;
    float mrun[2], lrun[2];
#pragma unroll
    for (int a = 0; a < 2; ++a) {
        if (ISB) { mrun[a] = sinks[hq] * LOG2E; lrun[a] = hh ? 0.f : 1.f; }
        else { mrun[a] = -1e30f; lrun[a] = 0.f; } }
    const LAS float* biasR = biasL + hq * 256;
    const float bconst = ISB ? 0.f : biasR[0];
    asm volatile("s_waitcnt vmcnt(0)" ::: "memory");
    for (int ib = 0; ib < nb; ++ib) {
        LAS unsigned char* slot = ring + (ib & 1) * 8192;
        if (ib >= 2) { if (ib + 1 < nb) asm volatile("s_waitcnt vmcnt(8)" ::: "memory"); else asm volatile("s_waitcnt vmcnt(0)" ::: "memory"); }
        attn_block<ISB>(slot, qf, o, mrun, lrun, kb0 + ib, r, hh, lane, biasR, bconst, qoff, nq);
        if (ib + 2 < nb) { asm volatile("s_waitcnt lgkmcnt(0)" ::: "memory"); __builtin_amdgcn_sched_barrier(0); kv_dma(Kp, Vp, blk0 + ib + 2, slot); }
    }
#pragma unroll
    for (int qb = 0; qb < 2; ++qb) {
        if (qb >= nq) continue;
        const float l = lrun[qb] + __shfl_xor(lrun[qb], 32), inv = 1.f / l;
        bf16_t* op = O + (size_t)(64 * u + qoff + 32 * qb + r) * DM + (ISB ? 512 : 0) + hq * 64 + 4 * hh;
#pragma unroll
        for (int db = 0; db < 2; ++db)
#pragma unroll
            for (int i4 = 0; i4 < 4; ++i4) { f32x4 v = {o[qb][db][4 * i4] * inv, o[qb][db][4 * i4 + 1] * inv, o[qb][db][4 * i4 + 2] * inv, o[qb][db][4 * i4 + 3] * inv};
                *(u32x2*)(op + 32 * db + 8 * i4) = pk4(v); }
    }
}

DI float wave_sum(float v) {
#pragma unroll
    for (int o = 1; o < 64; o <<= 1) v += __shfl_xor(v, o);
    return v;
}
DI void transpose_item(const float* W, int ldw, int k0, int n, bf16_t* WT, int Kd, int dst_row, const float* kscale) {
    float v[64];
#pragma unroll
    for (int i = 0; i < 64; ++i) v[i] = W[(size_t)(k0 + i) * ldw + n];
    if (kscale) {
#pragma unroll
        for (int i = 0; i < 64; ++i) v[i] *= kscale[k0 + i];
    }
    bf16_t* d = WT + (size_t)dst_row * Kd + k0;
#pragma unroll
    for (int c = 0; c < 8; ++c) { u32x4 o; o.x = pk2(v[8 * c], v[8 * c + 1]); o.y = pk2(v[8 * c + 2], v[8 * c + 3]); o.z = pk2(v[8 * c + 4], v[8 * c + 5]); o.w = pk2(v[8 * c + 6], v[8 * c + 7]);
        *(u32x4*)(d + 8 * c) = o; }
}
DI void vt_item(const float* src, int past, int nh, int band, int krows, bf16_t* VT, int item, int lane) {
    const int nrb = past / 32, rb = item % nrb, h = (item / nrb) % nh, b = item / (nrb * nh), r0 = rb * 32;
    float v[32];
#pragma unroll
    for (int i = 0; i < 32; ++i) v[i] = src[(((size_t)b * past + r0 + i) * nh + h) * 64 + lane];
    const int krow = SEQ + b * band + r0;
#pragma unroll
    for (int t = 0; t < 2; ++t)
#pragma unroll
        for (int hh = 0; hh < 2; ++hh) { const int k0 = 16 * t + 4 * hh; u32x4 o; o.x = pk2(v[k0], v[k0 + 1]); o.y = pk2(v[k0 + 2], v[k0 + 3]); o.z = pk2(v[k0 + 8], v[k0 + 9]); o.w = pk2(v[k0 + 10], v[k0 + 11]);
            *(u32x4*)(VT + vf_off(h, krows >> 5, krow + k0, lane)) = o; }
}

typedef const __attribute__((address_space(4))) Args* KArgs;
DI void prologue(KArgs ap, int gw, int NGW, int lane) {
    unsigned char* ws = ap->ws;
    const float *xp = ap->in[0], *xs = ap->in[1], *g_attn = ap->in[7], *w_in = ap->in[8];
    { unsigned* z = (unsigned*)(ws + WS_X1B); for (int i = gw * 64 + lane; i < 2 * DM / 2; i += NGW * 64) z[i] = 0u;
      if (gw == 1) { float* gd = (float*)(ws + WS_GAINS); gd[lane] = ap->in[9][lane]; gd[64 + lane] = ap->in[10][lane]; gd[128 + lane] = ap->in[12][lane]; gd[192 + lane] = ap->in[13][lane]; } }
    { float* rt = (float*)(ws + WS_ROPE);
      for (int e = gw * 64 + lane; e < SEQ * 32; e += NGW * 64) { const int pos = e >> 5, i = e & 31;
          const float inv = exp2f(-(float)i * (13.287712379549449f / 32.f));
          double rev = (double)pos * (double)inv * 0.15915494309189535; rev -= __builtin_rint(rev);
          const float fr_ = (float)rev; rt[2 * e] = __builtin_amdgcn_cosf(fr_); rt[2 * e + 1] = __builtin_amdgcn_sinf(fr_); } }
    for (int it = gw; it < 16 * 36; it += NGW) { const int kb = it / 36, hh = it % 36, bj = lane >> 5, x = lane & 31;
        transpose_item(w_in, NIN, 64 * kb, 64 * hh + lane, (bf16_t*)(ws + WS_WIN), DM, 256 * (hh >> 2) + 128 * bj + 32 * (hh & 3) + x, nullptr); }
    {
        f32x4 gg[4];
#pragma unroll
        for (int j = 0; j < 4; ++j) gg[j] = *((const f32x4*)g_attn + lane + 64 * j);
        bf16_t* XN = (bf16_t*)(ws + WS_XN);
        for (int m = gw; m < MTOK; m += NGW) {
            const f32x4* xr = (const f32x4*)(m < SEQ ? xp + (size_t)m * DM : xs + (size_t)(m - SEQ) * DM) + lane;
            f32x4 v[4]; float s = 0.f;
#pragma unroll
            for (int j = 0; j < 4; ++j) { v[j] = xr[64 * j]; s += (v[j][0] * v[j][0] + v[j][1] * v[j][1]) + (v[j][2] * v[j][2] + v[j][3] * v[j][3]); }
            const float rstd = rsqrtf(wave_sum(s) * (1.f / DM) + EPS);
            u32x2* o8 = (u32x2*)(XN + (size_t)m * DM) + lane;
#pragma unroll
            for (int j = 0; j < 4; ++j) o8[64 * j] = pk4(v[j] * rstd * gg[j]);
        }
    }
}
DI void kc_item(const float* src, int past, int nh, int band, int krows, bf16_t* KF, int item, int lane) {
    const int nrb = past / 32, h = item % nh, rb = (item / nh) % nrb, b = item / (nh * nrb), r = lane & 31, hh = lane >> 5;
    const float* sp = src + (((size_t)b * past + rb * 32 + r) * nh + h) * 64 + 8 * hh;
    bf16_t* d = KF + (((size_t)h * (krows >> 5) + ((SEQ + b * band) >> 5) + rb) * 4 * 64 + lane) * 8;
#pragma unroll
    for (int ds = 0; ds < 4; ++ds) { const f32x4 v0 = *(const f32x4*)(sp + 16 * ds), v1 = *(const f32x4*)(sp + 16 * ds + 4);
        u32x4 o; o.x = pk2(v0[0], v0[1]); o.y = pk2(v0[2], v0[3]); o.z = pk2(v1[0], v1[1]); o.w = pk2(v1[2], v1[3]);
        *(u32x4*)(d + ds * 512) = o; }
}
DI void prologue_b(KArgs ap, int gw, int NGW, int lane) {
    unsigned char* ws = ap->ws;
    const float *cak = ap->in[2], *cav = ap->in[3], *cbk = ap->in[4], *cbv = ap->in[5];
    for (int it = gw; it < NSTREAM * 16 * 8; it += NGW) kc_item(cak, 512, 8, 576, KA_ROWS, (bf16_t*)(ws + WS_KA), it, lane);
    for (int it = gw; it < NSTREAM * 4 * 2; it += NGW) kc_item(cbk, 128, 2, 192, KB_ROWS, (bf16_t*)(ws + WS_KB), it, lane);
    for (int it = gw; it < NSTREAM * 8 * 16; it += NGW) vt_item(cav, 512, 8, 576, KA_ROWS, (bf16_t*)(ws + WS_VTA), it, lane);
    for (int it = gw; it < NSTREAM * 2 * 4; it += NGW) vt_item(cbv, 128, 2, 192, KB_ROWS, (bf16_t*)(ws + WS_VTB), it, lane);
}
constexpr int WI_OUT = 16 * 16, WI_GU = 16 * 88, WI_DN = 44 * 16, WI_ALL = WI_OUT + WI_GU + WI_DN;
DI void weight_item(KArgs ap, int it, int lane) {
    unsigned char* ws = ap->ws;
    int r = it;
    if (r < WI_OUT) { const int kb = r / 16, nb = r % 16; transpose_item(ap->in[15], DM, 64 * kb, 64 * nb + lane, (bf16_t*)(ws + WS_WOUT), DM, 64 * nb + lane, nullptr); return; }
    r -= WI_OUT;
    if (r < WI_GU) { const int kb = r / 88, nb = r % 88; const int L = 64 * nb + lane; const int Lp = L < DFF ? L : L - DFF;
        transpose_item(ap->in[17], NGU, 64 * kb, L, (bf16_t*)(ws + WS_WGU), DM, 256 * (Lp >> 7) + (L < DFF ? 0 : 128) + (Lp & 127), ap->in[16]); return; }
    r -= WI_GU;
    { const int kb = r / 16, nb = r % 16; transpose_item(ap->in[20], DM, 64 * kb, 64 * nb + lane, (bf16_t*)(ws + WS_WDN), DFF, 64 * nb + lane, nullptr); }
}

#define XB_TMO      128
#define XB_XCNT(j)  (256  + 64 * (j))
#define XB_XSUB(j)  (1280 + 64 * (j))
#define XB_XGEN(j)  (2304 + 64 * (j))
#define XB_TOP      3328
#define XB_TOPGEN   3392
#define XCD_BAR_WORDS 3456
#define XB_SPIN_CAP (1u << 22)
DI unsigned xb_ld(unsigned* p)              { return __hip_atomic_load(p, __ATOMIC_RELAXED, __HIP_MEMORY_SCOPE_AGENT); }
DI unsigned xb_add(unsigned* p, unsigned v) { return __hip_atomic_fetch_add(p, v, __ATOMIC_RELAXED, __HIP_MEMORY_SCOPE_AGENT); }
DI unsigned xb_xcc_id() { return (unsigned)__builtin_amdgcn_s_getreg((3 << 11) | 20) & 0xFu; }
#define XB_SPIN(cond, bar) do { unsigned _sp = 0; while (cond) { __builtin_amdgcn_s_sleep(1); \
    if ((++_sp & 255u) == 0u) { if (xb_ld(&(bar)[XB_TMO])) break; if (_sp > XB_SPIN_CAP) { atomicAdd(&(bar)[XB_TMO], 1u); break; } } } } while (0)
struct XcdBarrier { unsigned* bar; unsigned x; volatile LAS unsigned* st; };
DI XcdBarrier xcd_barrier_post(unsigned* bar, volatile LAS unsigned* st) {
    XcdBarrier b; b.bar = bar; b.x = xb_xcc_id(); b.st = st;
    if (threadIdx.x == 0) (void)xb_add(&bar[XB_XCNT(b.x)], 1u);
    return b;
}
DI void xcd_barrier_complete(unsigned* bar, unsigned x, unsigned& nloc, unsigned& nx) {
    const unsigned G = gridDim.x * gridDim.y * gridDim.z;
    unsigned sum, cnt, mine, sp = 0u;
    for (;;) {
        sum = 0u; cnt = 0u; mine = 0u;
#pragma unroll
        for (unsigned j = 0; j < 16; ++j) { const unsigned c = xb_ld(&bar[XB_XCNT(j)]); sum += c; cnt += (c > 0u) ? 1u : 0u; mine = (j == x) ? c : mine; }
        if (sum == G) break;
        __builtin_amdgcn_s_sleep(1);
        if ((++sp & 255u) == 0u) { if (xb_ld(&bar[XB_TMO])) break; if (sp > XB_SPIN_CAP) { atomicAdd(&bar[XB_TMO], 1u); break; } }
    }
    nloc = mine > 0u ? mine : 1u; nx = cnt > 0u ? cnt : 1u;
}
DI void xcd_barrier(const XcdBarrier& b) {
    asm volatile("s_waitcnt vmcnt(0)" ::: "memory");
    __syncthreads();
    if (threadIdx.x == 0) {
        unsigned* bar = b.bar;
        __builtin_amdgcn_s_waitcnt(0);
        unsigned nloc = b.st[0], nx = b.st[1];
        if (nloc == 0u) { xcd_barrier_complete(bar, b.x, nloc, nx); b.st[0] = nloc; b.st[1] = nx; }
        const unsigned old = xb_add(&bar[XB_XSUB(b.x)], 1u);
        const unsigned gen = old / nloc;
        if (old + 1u == (gen + 1u) * nloc) {
            __builtin_amdgcn_fence(__ATOMIC_RELEASE, "agent");
            asm volatile("s_waitcnt vmcnt(0)" ::: "memory");
            const unsigned og = xb_add(&bar[XB_TOP], 1u);
            const unsigned tg = og / nx;
            if (og + 1u == (tg + 1u) * nx) xb_add(&bar[XB_TOPGEN], 1u);
            else XB_SPIN(xb_ld(&bar[XB_TOPGEN]) == tg, bar);
            __builtin_amdgcn_fence(__ATOMIC_ACQUIRE, "agent");
            xb_add(&bar[XB_XGEN(b.x)], 1u);
            asm volatile("s_waitcnt vmcnt(0)" ::: "memory");
        } else {
            XB_SPIN(xb_ld(&bar[XB_XGEN(b.x)]) == gen, bar);
            __builtin_amdgcn_fence(__ATOMIC_ACQUIRE, "agent");
            asm volatile("s_waitcnt vmcnt(0)" ::: "memory");
        }
    }
    __syncthreads();
}

__global__ void __launch_bounds__(512, 2) fwd_kernel(Args a_byval) {
    KArgs kp = (KArgs)__builtin_amdgcn_kernarg_segment_ptr();
#define KP() ({ KArgs _p = kp; asm volatile("" : "+s"(_p)); _p; })
    extern __shared__ __attribute__((aligned(16))) unsigned char lds_raw[];
    LAS unsigned char* lds = (LAS unsigned char*)lds_raw;
    const int tid = threadIdx.x, lane = tid & 63, wave = __builtin_amdgcn_readfirstlane(tid >> 6);
    const int G = gridDim.x, bx = blockIdx.x;
    const int lo = kp->ph_lo, hi = kp->ph_hi;
    unsigned char* ws = kp->ws;
#define IN(k) (lo <= (k) && (k) < hi)
#define SEAM(k) do { if (IN(k) && IN((k) + 1)) { for (int _r = 0; _r < 1 + 4 * (NREP(5) - 1); ++_r) xcd_barrier(bar); } } while (0)
    volatile LAS unsigned* MISC = (volatile LAS unsigned*)(lds + RING_BYTES + 8192);
    if (tid < 4) MISC[tid] = 0u;
    __syncthreads();
    XcdBarrier bar; bar.bar = (unsigned*)(ws + WS_BAR); bar.x = 0; bar.st = MISC;
    if (hi - lo > 1 || lo == 3) bar = xcd_barrier_post((unsigned*)(ws + WS_BAR), MISC);
    if (hi > 1000) cg::this_grid().sync();

    if (IN(0)) { for (int rep = 0; rep < NREP(0); ++rep) prologue(KP(), bx * 8 + wave, G * 8, lane); }
    SEAM(0);
    if (IN(1)) {
        pg8::Gemm g{(const bf16_t*)(ws + WS_XN), (const bf16_t*)(ws + WS_WIN), DM};
        pg8::Order<0> S; S.init(MTOK / 256, NIN / 256, G, bx, DM / 64);
        EpiQKV E{(const float*)(ws + WS_GAINS), ws, KP()->out};
        if (NREP(1) == 2) { EpiNull EN; pg8::gemm_phase<EpiNull, pg8::Order<0>, true>(lds, g, S, EN); }
        pg8::gemm_phase<EpiQKV, pg8::Order<0>, true>(lds, g, S, E);
        if (bx >= 136) prologue_b(KP(), (bx - 136) * 8 + wave, (G - 136) * 8, lane);
    }
    SEAM(1);
    if (IN(2)) {
        LAS float* biasL = (LAS float*)(lds + RING_BYTES + 8448);
        { const float* tab = KP()->in[11]; for (int i = tid; i < 8 * 256; i += 512) { const int h = i >> 8, uu = i & 255; int d = 191 - uu; d = d > 128 ? 128 : d; biasL[i] = tab[h * 257 + d + 128] * LOG2E; } }
        const float* sinks = KP()->in[14];
        __syncthreads();
        volatile LAS unsigned* wctr = (volatile LAS unsigned*)(lds + RING_BYTES + 8192 + 64);
        if (tid == 0) *wctr = 0u;
        __syncthreads();
        for (;;) {
            unsigned k = 0; if (lane == 0) k = __hip_atomic_fetch_add((LAS unsigned*)(lds + RING_BYTES + 8192 + 64), 1u, __ATOMIC_RELAXED, __HIP_MEMORY_SCOPE_WORKGROUP);
            k = __builtin_amdgcn_readfirstlane(k);
            if (k >= 19u * NREP(2)) {
                const int it = bx + 256 * (int)(k - 19u * NREP(2));
                if (it >= WI_ALL) break;
                weight_item(KP(), it, lane); continue; }
            if (k >= 19u) k -= 19u;
            if (k < 10u) { const unsigned i = (unsigned)bx + 256u * (k < 8u ? k : 8u); const int nq = k < 8u ? 2 : 1, qoff = k == 9u ? 32 : 0;
                attn_unit<false>(287 - (int)(i >> 3), (int)(i & 7), qoff, nq, (const bf16_t*)(ws + WS_QA), (const bf16_t*)(ws + WS_KA), (const bf16_t*)(ws + WS_VTA), (bf16_t*)(ws + WS_O), nullptr, biasL, lds + wave * 16384, lane); }
            else { const unsigned i = (unsigned)bx + 256u * (k - 10u); attn_unit<true>(287 - (int)(i >> 3), (int)(i & 7), 0, 2, (const bf16_t*)(ws + WS_QB), (const bf16_t*)(ws + WS_KB), (const bf16_t*)(ws + WS_VTB), (bf16_t*)(ws + WS_O), sinks, biasL, lds + wave * 16384, lane); }
        }
        __syncthreads();
    }
    SEAM(2);
    if (IN(3)) {
        const int v = (bx & 7) * 32 + (bx >> 3), x = bx & 7, j = bx >> 3;
#pragma unroll 1
        for (int step = 0; step < 6; ++step) {
            int kind, rs, rstr = 32, rc;
            if (step == 0) { kind = 3; rs = v; rc = 1; }
            else if (step == 1) { kind = 3; rs = 256 + 4 * x + j; rc = j < 4 ? 1 : 0; }
            else if (step == 2) { kind = 4; rs = 88 * x + j; rstr = 28; rc = j < 4 ? 1 : 3; }
            else if (step == 3) { kind = 5; rs = 4 * x + j; rc = j < 4 ? 1 : 0; }
            else if (step == 4) { kind = 4; const int base = 704 + (x < 6 ? 113 * x : 678 + 112 * (x - 6)), r = (x < 6 ? 25 : 24);
                if (j < 4) { rs = base + j; rc = 1; } else { const int jj = j - 4; rs = base + 4 + jj; rstr = 28; rc = 3 + (jj < r ? 1 : 0); } }
            else { kind = 5; rs = 32 + v; rc = 1; }
            if (kind == 3) {
                pg8::Gemm g{(const bf16_t*)(ws + WS_O), (const bf16_t*)(ws + WS_WOUT), DM};
                pg8::RangeOrder<3> S{rs, rstr, rc};
                KArgs q = KP(); EpiOut E{q->in[0], q->in[1], q->out, (bf16_t*)(ws + WS_X1B), (float*)(ws + WS_SUMSQ)};
                if (NREP(8) == 2) { EpiNull EN; pg8::gemm_phase<EpiNull, pg8::RangeOrder<3>, true>(lds, g, S, EN); }
                pg8::gemm_phase<EpiOut, pg8::RangeOrder<3>, true>(lds, g, S, E);
            } else if (kind == 4) {
                pg8::Gemm g{(const bf16_t*)(ws + WS_X1B), (const bf16_t*)(ws + WS_WGU), DM};
                pg8::RangeOrder<4> S{rs, rstr, rc};
                KArgs q = KP(); EpiGU E{(const float*)(ws + WS_SUMSQ), q->in[18], q->in[19], q->in[6], (bf16_t*)(ws + WS_Y), q->out};
#pragma nounroll
                for (int rep = 0; rep < NREP(3); ++rep) pg8::gemm_phase<EpiGU, pg8::RangeOrder<4>, true>(lds, g, S, E);
            } else {
                pg8::Gemm g{(const bf16_t*)(ws + WS_Y), (const bf16_t*)(ws + WS_WDN), DFF};
                pg8::RangeOrder<5> S{rs, rstr, rc};
                EpiDown E{KP()->out, (const bf16_t*)(ws + WS_X1B)};
                if (NREP(9) == 2) { EpiNull EN; pg8::gemm_phase<EpiNull, pg8::RangeOrder<5>, true>(lds, g, S, EN); }
                pg8::gemm_phase<EpiDown, pg8::RangeOrder<5>, true>(lds, g, S, E);
            }
            if (step == 0 || step == 2 || step == 4) xcd_barrier(bar);
        }
    }
#undef IN
#undef SEAM
}

extern "C" void kernel_launch(void* const* d_in, const int* in_sizes, int n_in, void* d_out, int out_size, void* d_ws, size_t ws_size, hipStream_t stream) {
    static int grid = 0;
    if (grid == 0) {
        int dev = 0, cus = 0, per_cu = 0;
        hipGetDevice(&dev);
        hipDeviceGetAttribute(&cus, hipDeviceAttributeMultiprocessorCount, dev);
        if (hipFuncSetAttribute((const void*)fwd_kernel, hipFuncAttributeMaxDynamicSharedMemorySize, LDS_BYTES) != hipSuccess) { fprintf(stderr, "hipFuncSetAttribute failed\n"); grid = -1; return; }
        if (hipOccupancyMaxActiveBlocksPerMultiprocessor(&per_cu, (const void*)fwd_kernel, 512, LDS_BYTES) != hipSuccess || per_cu < 1) { fprintf(stderr, "occupancy query: %d\n", per_cu); per_cu = 1; }
        (void)hipGetLastError();
        grid = 256;
        if (cus != 256) fprintf(stderr, "note: device reports %d CUs; this kernel is laid out for 256\n", cus);
        if (n_in != 21 || ws_size < 256 * MiB) { fprintf(stderr, "unexpected n_in %d / ws %zu\n", n_in, ws_size); grid = -1; return; }
    }
    if (grid < 0) return;
    if (hipMemsetAsync((char*)d_ws + WS_CTL, 0, CTL_ZERO_BYTES, stream) != hipSuccess) { fprintf(stderr, "memset failed\n"); return; }
    Args a{};
    for (int i = 0; i < 21; ++i) a.in[i] = (const float*)d_in[i];
    a.out = (float*)d_out; a.ws = (unsigned char*)d_ws;
#if N_LAUNCH_MODE == 1
    a.ph_lo = 0; a.ph_hi = 4;
    void* args[] = {&a};
    hipError_t e = hipLaunchCooperativeKernel((const void*)fwd_kernel, dim3(grid), dim3(512), args, LDS_BYTES, stream);
    if (e != hipSuccess) fprintf(stderr, "cooperative launch failed: %s (grid %d)\n", hipGetErrorString(e), grid);
#else
    for (int p = 0; p < 4; ++p) { a.ph_lo = p; a.ph_hi = p + 1; hipLaunchKernelGGL(fwd_kernel, dim3(grid), dim3(512), LDS_BYTES, stream, a); }
#endif
}
```

```cpp
#include <hip/hip_runtime.h>
#include <hip/hip_cooperative_groups.h>
#include <cstdio>
#include <cstdint>
namespace cg = cooperative_groups;

#ifndef N_LAUNCH_MODE
#define N_LAUNCH_MODE 1
#endif

#ifndef REP
#define REP 0
#endif
#define NREP(k) ((((REP) >> (k)) & 1) + 1)
#ifndef PROBE_EPI
#define PROBE_EPI 1
#endif
#define LAS __attribute__((address_space(3)))
#define DI __device__ __forceinline__
typedef unsigned short bf16_t;
typedef short bf16x8 __attribute__((ext_vector_type(8)));
typedef short s16x4 __attribute__((ext_vector_type(4)));
typedef float f32x4 __attribute__((ext_vector_type(4)));
typedef float f32x16 __attribute__((ext_vector_type(16)));
typedef unsigned u32x4 __attribute__((ext_vector_type(4)));
typedef unsigned u32x2 __attribute__((ext_vector_type(2)));

constexpr int DM = 1024, SEQ = 16384, NSTREAM = 32, DSEQ = 64, MTOK = SEQ + NSTREAM * DSEQ;
constexpr int NIN = 2304, DFF = 2816, NGU = 2 * DFF;
constexpr int KA_ROWS = SEQ + NSTREAM * 576;
constexpr int KB_ROWS = SEQ + NSTREAM * 192;
constexpr int X1B_PROMPT_ROWS = 16512;
constexpr int GU_PT = 65;
constexpr float EPS = 1e-6f, LOG2E = 1.4426950408889634f;
constexpr float QSCALE = 0.125f * LOG2E;
constexpr size_t OFF_AKP = 18874368, OFF_AVP = 19136512, OFF_BKP = 19398656, OFF_BVP = 19415040, OFF_CVP = 19431424;
constexpr size_t OFF_AKS = 19437056, OFF_AVS = 20485632, OFF_BKS = 21534208, OFF_BVS = 21796352, OFF_CVS = 22058496;
constexpr size_t MiB = 1u << 20;
constexpr size_t WS_CTL = 0, WS_GAINS = 4096, WS_BAR = 16384, WS_SUMSQ = 65536, CTL_ZERO_BYTES = 160 * 1024;
constexpr size_t WS_WIN = 1 * MiB, WS_WOUT = 6 * MiB, WS_WGU = 8 * MiB, WS_WDN = 19 * MiB;
constexpr size_t WS_X1B = 25 * MiB, WS_O = 62 * MiB, WS_VTA = 98 * MiB, WS_KB = 132 * MiB, WS_VTB = 138 * MiB;
constexpr size_t WS_XN = 144 * MiB, WS_QA = 180 * MiB, WS_QB = 198 * MiB, WS_KA = 216 * MiB;
constexpr size_t WS_ROPE = 250 * MiB;
constexpr size_t WS_Y = 144 * MiB;
constexpr int LDS_BYTES = 155648, RING_BYTES = 131072;

struct Args { const float* in[21]; float* out; unsigned char* ws; int ph_lo, ph_hi; };

DI unsigned pk2(float lo, float hi) {
    typedef float f2 __attribute__((ext_vector_type(2))); typedef __bf16 b2 __attribute__((ext_vector_type(2)));
    f2 v = {lo, hi}; b2 b = __builtin_convertvector(v, b2); return __builtin_bit_cast(unsigned, b);
}
DI size_t kf_off(int h, int nblk, int krow, int d) { return ((((size_t)h * nblk + (krow >> 5)) * 4 + (d >> 4)) * 64 + ((d >> 3) & 1) * 32 + (krow & 31)) * 8 + (d & 7); }
DI size_t vf_off(int h, int nblk, int krow, int d) { const int kk = krow & 31; return (((((size_t)h * nblk + (krow >> 5)) * 2 + (d >> 5)) * 2 + (kk >> 4)) * 64 + ((kk >> 2) & 1) * 32 + (d & 31)) * 8 + 4 * ((kk >> 3) & 1) + (kk & 3); }
DI u32x2 pk4(f32x4 v) { u32x2 r; r.x = pk2(v[0], v[1]); r.y = pk2(v[2], v[3]); return r; }

namespace pg8 {
constexpr int BM = 256, BK = 64, HALF = 128, HTB = HALF * BK * 2, NXCD = 8, WGM = 8;
DI int lds_byte(int r, int c) { const int st = (r >> 4) * 2 + (c >> 5), rr = r & 15, cc = c & 31, ob = rr * 64 + cc * 2; return st * 1024 + (ob ^ (((ob >> 9) & 1) << 5)); }
DI void stage_rc(int b, int& R, int& C) { const int st = b / 1024, sb = b % 1024, swz = sb ^ (((sb >> 9) & 1) << 5); R = (st >> 1) * 16 + swz / 64; C = (st & 1) * 32 + (swz % 64) / 2; }

struct Unit { int pm, pn, kt0, nkt; };
struct Gemm { const bf16_t* A; const bf16_t* Bt; int K; };

template <int GU> struct Order {
    int nM, nN, nwg, G, c, nkt;
    DI void init(int nM_, int nN_, int G_, int c_, int nkt_) { nM = nM_; nN = nN_; nwg = nM * nN; G = G_; c = c_; nkt = nkt_; }
    DI bool next(int i, Unit& u) const {
        const long L = (long)i * G + c; if (L >= nwg) return false;
        u.kt0 = 0; u.nkt = nkt;
        int wgid = (int)L; { const int q = nwg / NXCD, r = nwg % NXCD, xcd = wgid % NXCD, off = wgid / NXCD; wgid = (xcd < r ? xcd * (q + 1) : r * (q + 1) + (xcd - r) * q) + off; }
        const int nig = WGM * nN, gid = wgid / nig, fm = gid * WGM, gsz = (nM - fm) < WGM ? (nM - fm) : WGM;
        u.pm = fm + ((wgid % nig) % gsz); u.pn = (wgid % nig) / gsz; return true;
    }
    DI size_t a_row(int pm) const { return GU ? (size_t)(pm < GU_PT ? 254 * pm : X1B_PROMPT_ROWS + 256 * (pm - GU_PT)) : (size_t)pm * 256; }
};

template <int KIND> struct RangeOrder {
    int s, stride, cnt;
    DI bool next(int i, Unit& u) const {
        if (i >= cnt) return false;
        const int idx = s + i * stride;
        if (KIND == 4) { const int g = idx / 176, w = idx - 176 * g, gsz = (73 - 8 * g) < 8 ? (73 - 8 * g) : 8;
            u.pm = 8 * g + w % gsz; u.pn = w / gsz; u.kt0 = 0; u.nkt = 16; }
        else { u.pm = idx >> 2; u.pn = idx & 3; u.kt0 = 0; u.nkt = KIND == 5 ? 44 : 16; }
        return true;
    }
    DI size_t a_row(int pm) const { return KIND == 4 ? (size_t)(pm < GU_PT ? 254 * pm : X1B_PROMPT_ROWS + 256 * (pm - GU_PT)) : (size_t)pm * 256; }
};
struct OrderSK {
    static constexpr int NP = 22, NU = 288;
    int s, e;
    DI void init(int G, int c) { const int v = (G % 8 == 0) ? (c % 8) * (G / 8) + c / 8 : c; s = (int)((long)v * (NU * NP) / G); e = (int)((long)(v + 1) * (NU * NP) / G); }
    DI bool next(int i, Unit& u) const {
        int p = s;
        for (int k = 0; k < i; ++k) p = (p / NP + 1) * NP;
        if (p >= e) return false;
        const int unit = p / NP, pe = (unit + 1) * NP < e ? (unit + 1) * NP : e;
        u.kt0 = (p - unit * NP) * 2; u.nkt = (pe - p) * 2;
        u.pm = (unit >> 5) * 8 + (unit & 7); u.pn = (unit & 31) >> 3; return true;
    }
    DI size_t a_row(int pm) const { return (size_t)pm * 256; }
};

template <class Epi, class Sched, bool ALIGN_EPI>
DI void gemm_phase(LAS unsigned char* lds, const Gemm g, const Sched& S, const Epi& E) {
    const int tid = threadIdx.x, wid = __builtin_amdgcn_readfirstlane(tid >> 6), lane = tid & 63, wr = wid >> 2, wc = wid & 3, fr = lane & 15, fq = lane >> 4;
    const int K = g.K;
    unsigned voffA[2];
#pragma unroll
    for (int i = 0; i < 2; ++i) { int R, C; stage_rc(tid * 16 + i * 8192, R, C); voffA[i] = (unsigned)(R * K + C) * 2u; }
    const size_t kstep = (size_t)(BK * 2);
    const size_t hstep = (size_t)HALF * K * 2;
    const size_t rowb = (size_t)K * 2;
    const unsigned ldsw = (unsigned)wid * 1024u;
    const int aoff = lds_byte(wr * 64 + fr, fq * 8), boff = lds_byte(wc * 32 + fr, fq * 8);
#define PG8_SA(b, h) (((b) * 2 + (h)) * HTB)
#define PG8_SB(b, h) ((4 + (b) * 2 + (h)) * HTB)
#define PG8_STAGE(bufoff, gbase, voff) do { _Pragma("unroll") for (int _i = 0; _i < 2; ++_i) \
        __builtin_amdgcn_global_load_lds((const unsigned*)((const char*)(gbase) + (voff)[_i]), (LAS unsigned*)(lds + (bufoff) + ldsw + _i * 8192), 16, 0, 0); } while (0)
#define PG8_LDA(dst, b, h) do { _Pragma("unroll") for (int m = 0; m < 4; ++m) _Pragma("unroll") for (int k = 0; k < 2; ++k) dst[m][k] = *(const LAS bf16x8*)(lds + PG8_SA(b, h) + aoff + m * 2048 + k * 1024); } while (0)
#define PG8_LDB(dst, b, h) do { _Pragma("unroll") for (int n = 0; n < 2; ++n) _Pragma("unroll") for (int k = 0; k < 2; ++k) dst[n][k] = *(const LAS bf16x8*)(lds + PG8_SB(b, h) + boff + n * 2048 + k * 1024); } while (0)
#define PG8_MMA(ai, bj, At, Bt) do { __builtin_amdgcn_s_setprio(1); _Pragma("unroll") for (int m = 0; m < 4; ++m) _Pragma("unroll") for (int n = 0; n < 2; ++n) _Pragma("unroll") for (int k = 0; k < 2; ++k) \
        acc[ai][bj][m][n] = __builtin_amdgcn_mfma_f32_16x16x32_bf16(Bt[n][k], At[m][k], acc[ai][bj][m][n], 0, 0, 0); __builtin_amdgcn_s_setprio(0); } while (0)
#define PG8_WAIT_V(n) asm volatile("s_waitcnt vmcnt(" #n ")" ::: "memory")
#define PG8_WAIT_L(n) asm volatile("s_waitcnt lgkmcnt(" #n ")" ::: "memory")
#define PG8_BAR __builtin_amdgcn_s_barrier()
#define PG8_SCHED __builtin_amdgcn_sched_barrier(0)
    Unit cur, nxt; int ui = 0;
    if (!S.next(0, cur)) return;
    f32x4 acc[2][2][4][2];
#pragma unroll
    for (int a = 0; a < 2; ++a)
#pragma unroll
        for (int b = 0; b < 2; ++b)
#pragma unroll
            for (int m = 0; m < 4; ++m)
#pragma unroll
                for (int n = 0; n < 2; ++n) acc[a][b][m][n] = (f32x4){0.f, 0.f, 0.f, 0.f};
    bf16x8 At[4][2], B0[2][2], B1[2][2];
    const char* cA = (const char*)g.A + S.a_row(cur.pm) * rowb + (size_t)cur.kt0 * kstep; const char* cB = (const char*)g.Bt + (size_t)cur.pn * 2 * hstep + (size_t)cur.kt0 * kstep;
    PG8_STAGE(PG8_SB(0, 0), cB, voffA); PG8_STAGE(PG8_SB(0, 1), cB + hstep, voffA); PG8_STAGE(PG8_SA(0, 0), cA, voffA); PG8_STAGE(PG8_SA(0, 1), cA + hstep, voffA);
    if (wr == 1) PG8_BAR;
    PG8_WAIT_V(2); PG8_BAR;
    PG8_STAGE(PG8_SB(1, 0), cB + kstep, voffA); PG8_STAGE(PG8_SA(1, 0), cA + kstep, voffA); PG8_STAGE(PG8_SB(1, 1), cB + hstep + kstep, voffA);
    PG8_WAIT_V(6); PG8_BAR;
    for (;;) {
        const bool has_next = S.next(ui + 1, nxt);
        const char* nA = has_next ? (const char*)g.A + S.a_row(nxt.pm) * rowb + (size_t)nxt.kt0 * kstep : cA; const char* nB = has_next ? (const char*)g.Bt + (size_t)nxt.pn * 2 * hstep + (size_t)nxt.kt0 * kstep : cB;
        const int nt = cur.nkt;
        for (int t = 0; t < nt; t += 2) {
            const bool last = (t == nt - 2);
            const char* a1 = cA + (size_t)(t + 1) * kstep;
            const char* a2 = last ? nA : cA + (size_t)(t + 2) * kstep; const char* b2 = last ? nB : cB + (size_t)(t + 2) * kstep;
            const char* a3 = a2 + kstep; const char* b3 = b2 + kstep;
            PG8_LDB(B0, 0, 0); PG8_LDB(B1, 0, 1); PG8_SCHED; PG8_LDA(At, 0, 0); PG8_STAGE(PG8_SA(1, 1), a1 + hstep, voffA);
            PG8_WAIT_V(8); PG8_WAIT_L(0); PG8_BAR; PG8_MMA(0, 0, At, B0); PG8_MMA(0, 1, At, B1); PG8_BAR; PG8_SCHED;
            PG8_LDA(At, 0, 1); PG8_STAGE(PG8_SB(0, 0), b2, voffA); PG8_STAGE(PG8_SB(0, 1), b2 + hstep, voffA); PG8_STAGE(PG8_SA(0, 0), a2, voffA);
            PG8_WAIT_V(8); PG8_WAIT_L(0); PG8_BAR; PG8_MMA(1, 0, At, B0); PG8_MMA(1, 1, At, B1); PG8_BAR; PG8_SCHED;
            PG8_LDB(B0, 1, 0); PG8_LDB(B1, 1, 1); PG8_SCHED; PG8_LDA(At, 1, 0); PG8_STAGE(PG8_SA(0, 1), a2 + hstep, voffA);
            PG8_WAIT_V(8); PG8_WAIT_L(0); PG8_BAR; PG8_MMA(0, 0, At, B0); PG8_MMA(0, 1, At, B1); PG8_BAR; PG8_SCHED;
            PG8_LDA(At, 1, 1); PG8_STAGE(PG8_SB(1, 0), b3, voffA); PG8_STAGE(PG8_SB(1, 1), b3 + hstep, voffA); PG8_STAGE(PG8_SA(1, 0), a3, voffA);
            PG8_WAIT_V(8); PG8_WAIT_L(0); PG8_BAR; PG8_MMA(1, 0, At, B0); PG8_MMA(1, 1, At, B1); PG8_BAR; PG8_SCHED;
        }
        if constexpr (ALIGN_EPI) { if (wr == 0) PG8_BAR; }
        E(acc, cur, wr, wc, fr, fq, lds + RING_BYTES);
        if constexpr (NREP(7) == 2 && Epi::PROBE2) E(acc, cur, wr, wc, fr, fq, lds + RING_BYTES);
        if (!has_next) break;
#pragma unroll
        for (int a = 0; a < 2; ++a)
#pragma unroll
            for (int b = 0; b < 2; ++b)
#pragma unroll
                for (int m = 0; m < 4; ++m)
#pragma unroll
                    for (int n = 0; n < 2; ++n) acc[a][b][m][n] = (f32x4){0.f, 0.f, 0.f, 0.f};
        cur = nxt; cA = nA; cB = nB; ++ui;
        if constexpr (ALIGN_EPI) { if (wr == 1) PG8_BAR; }
    }
    PG8_WAIT_V(0);
    if constexpr (!ALIGN_EPI) { if (wr == 0) PG8_BAR; }
    PG8_BAR;
#undef PG8_SA
#undef PG8_SB
#undef PG8_STAGE
#undef PG8_LDA
#undef PG8_LDB
#undef PG8_MMA
#undef PG8_WAIT_V
#undef PG8_WAIT_L
#undef PG8_BAR
#undef PG8_SCHED
}
}
using pg8::Unit;
typedef f32x4 AccT[2][2][4][2];

struct EpiQKV {
    static constexpr bool PROBE2 = (PROBE_EPI == 1);
    const float* gains;
    unsigned char* ws; float* out;
    DI void operator()(const AccT& acc, const Unit& u, int wr, int wc, int fr, int fq, LAS unsigned char*) const {
        const int hh = u.pn * 4 + wc;
        int kind, h;
        if (hh < 8) { kind = 0; h = hh; } else if (hh < 16) { kind = 1; h = hh - 8; } else if (hh < 24) { kind = 2; h = hh - 16; }
        else if (hh < 32) { kind = 3; h = hh - 24; } else if (hh < 34) { kind = 4; h = hh - 32; } else { kind = 5; h = hh - 34; }
        const bool donorm = (kind != 2 && kind != 5), dorope = (kind == 3 || kind == 4);
        const float* gain = gains + 64 * (kind == 0 ? 0 : (kind == 1 ? 1 : (kind == 3 ? 2 : 3)));
        f32x4 gv[2][2];
#pragma unroll
        for (int bj = 0; bj < 2; ++bj)
#pragma unroll
            for (int n = 0; n < 2; ++n) gv[bj][n] = donorm ? *(const f32x4*)(gain + 32 * bj + 16 * n + 4 * fq) : (f32x4){1.f, 1.f, 1.f, 1.f};
#pragma unroll
        for (int ai = 0; ai < 2; ++ai)
#pragma unroll
            for (int m = 0; m < 4; ++m) {
                const int row = u.pm * 256 + ai * 128 + wr * 64 + m * 16 + fr;
                f32x4 v[2][2];
#pragma unroll
                for (int bj = 0; bj < 2; ++bj)
#pragma unroll
                    for (int n = 0; n < 2; ++n) v[bj][n] = acc[ai][bj][m][n];
                if (donorm) {
                    float ss = 0.f;
#pragma unroll
                    for (int bj = 0; bj < 2; ++bj)
#pragma unroll
                        for (int n = 0; n < 2; ++n) ss += (v[bj][n][0] * v[bj][n][0] + v[bj][n][1] * v[bj][n][1]) + (v[bj][n][2] * v[bj][n][2] + v[bj][n][3] * v[bj][n][3]);
                    ss += __shfl_xor(ss, 16); ss += __shfl_xor(ss, 32);
                    const float rs = rsqrtf(ss * (1.f / 64.f) + EPS);
#pragma unroll
                    for (int bj = 0; bj < 2; ++bj)
#pragma unroll
                        for (int n = 0; n < 2; ++n) v[bj][n] = v[bj][n] * rs * gv[bj][n];
                }
                if (dorope) {
                    const int pos = row < SEQ ? row : 1024 + ((row - SEQ) & 63);
                    const f32x4* rt = (const f32x4*)((const float*)(ws + WS_ROPE) + ((size_t)pos * 32 + 4 * fq) * 2);
#pragma unroll
                    for (int n = 0; n < 2; ++n) {
                        const f32x4 t0 = rt[8 * n], t1 = rt[8 * n + 1];
                        const float cs[4] = {t0[0], t0[2], t1[0], t1[2]}, sn[4] = {t0[1], t0[3], t1[1], t1[3]};
#pragma unroll
                        for (int j = 0; j < 4; ++j) { const float x1 = v[0][n][j], x2 = v[1][n][j]; v[0][n][j] = x1 * cs[j] - x2 * sn[j]; v[1][n][j] = x2 * cs[j] + x1 * sn[j]; }
                    }
                }
                if (kind == 0 || kind == 3) {
                    bf16_t* q = (bf16_t*)(ws + (kind == 0 ? WS_QA : WS_QB)) + ((size_t)h * MTOK + row) * 64 + 4 * fq;
#pragma unroll
                    for (int bj = 0; bj < 2; ++bj)
#pragma unroll
                        for (int n = 0; n < 2; ++n) *(u32x2*)(q + 32 * bj + 16 * n) = pk4(v[bj][n] * QSCALE);
                } else {
                    const bool isA = (kind == 1 || kind == 2), isK = (kind == 1 || kind == 4);
                    const int srow = row - SEQ;
                    const int band = isA ? 576 : 192, past = isA ? 512 : 128, nh = isA ? 8 : 2;
                    const int krow = row < SEQ ? row : SEQ + (srow >> 6) * band + past + (srow & 63);
                    const int krows = isA ? KA_ROWS : KB_ROWS;
                    float* op = nullptr;
                    size_t ooff = 0; bool has_o = false;
                    if (row >= SEQ) { ooff = (isA ? (isK ? OFF_AKS : OFF_AVS) : (isK ? OFF_BKS : OFF_BVS)) + ((size_t)srow * nh + h) * 64; has_o = true; }
                    else if (row >= SEQ - past) { ooff = (isA ? (isK ? OFF_AKP : OFF_AVP) : (isK ? OFF_BKP : OFF_BVP)) + ((size_t)(row - (SEQ - past)) * nh + h) * 64; has_o = true; }
                    op = out + ooff;
                    if (has_o) {
#pragma unroll
                        for (int bj = 0; bj < 2; ++bj)
#pragma unroll
                            for (int n = 0; n < 2; ++n) *(f32x4*)(op + 32 * bj + 16 * n + 4 * fq) = v[bj][n];
                    }
                    if (isK) {
                        bf16_t* kp = (bf16_t*)(ws + (isA ? WS_KA : WS_KB));
#pragma unroll
                        for (int bj = 0; bj < 2; ++bj)
#pragma unroll
                            for (int n = 0; n < 2; ++n) *(u32x2*)(kp + kf_off(h, krows >> 5, krow, 32 * bj + 16 * n + 4 * fq)) = pk4(v[bj][n]);
                    } else {
                        bf16_t* vp = (bf16_t*)(ws + (isA ? WS_VTA : WS_VTB));
#pragma unroll
                        for (int bj = 0; bj < 2; ++bj)
#pragma unroll
                            for (int n = 0; n < 2; ++n)
#pragma unroll
                                for (int j = 0; j < 4; ++j) {
                                    const float mine = v[bj][n][j], oth = __shfl_xor(mine, 1);
                                    if (!(fr & 1)) *(unsigned*)(vp + vf_off(h, krows >> 5, krow, 32 * bj + 16 * n + 4 * fq + j)) = pk2(mine, oth);
                                }
                    }
                }
            }
    }
};

struct EpiNull {
    static constexpr bool PROBE2 = false;
    DI void operator()(const AccT& acc, const Unit& u, int wr, int wc, int fr, int fq, LAS unsigned char*) const {
#pragma unroll
        for (int ai = 0; ai < 2; ++ai)
#pragma unroll
            for (int bj = 0; bj < 2; ++bj)
#pragma unroll
                for (int m = 0; m < 4; ++m)
#pragma unroll
                    for (int n = 0; n < 2; ++n) asm volatile("" :: "v"(acc[ai][bj][m][n]));
    }
};
struct EpiOut {
    static constexpr bool PROBE2 = false;
    const float *xp, *xs; float* out; bf16_t* X1B; float* sumsq;
    DI void operator()(const AccT& acc, const Unit& u, int wr, int wc, int fr, int fq, LAS unsigned char*) const {
        const int col0 = u.pn * 256 + wc * 32 + 4 * fq;
#pragma unroll
        for (int ai = 0; ai < 2; ++ai)
#pragma unroll
            for (int m = 0; m < 4; ++m) {
                const int row = u.pm * 256 + ai * 128 + wr * 64 + m * 16 + fr;
                const float* xr = (row < SEQ ? xp + (size_t)row * DM : xs + (size_t)(row - SEQ) * DM) + col0;
                bf16_t* brow = X1B + (size_t)(row < SEQ ? row + 2 : row + (X1B_PROMPT_ROWS - SEQ)) * DM + col0;
                float ss = 0.f;
#pragma unroll
                for (int bj = 0; bj < 2; ++bj)
#pragma unroll
                    for (int n = 0; n < 2; ++n) {
                        const int c = bj * 128 + n * 16;
                        const f32x4 o = *(const f32x4*)(xr + c) + acc[ai][bj][m][n];
                        *(u32x2*)(brow + c) = pk4(o);
                        ss += (o[0] * o[0] + o[1] * o[1]) + (o[2] * o[2] + o[3] * o[3]);
                    }
                ss += __shfl_xor(ss, 16); ss += __shfl_xor(ss, 32);
                if (fq == 0) unsafeAtomicAdd(sumsq + row, ss);
            }
    }
};

struct EpiGU {
    static constexpr bool PROBE2 = (PROBE_EPI == 4);
    const float *sumsq, *convw, *convb, *state; bf16_t* Y; float* out;
    DI void operator()(const AccT& acc, const Unit& u, int wr, int wc, int fr, int fq, LAS unsigned char* ldsx) const {
        LAS float* H = (LAS float*)ldsx;
        const int T = u.pm; const bool prompt = T < GU_PT, lastT = (T == GU_PT - 1);
        const int tok0 = (prompt ? 254 * T - 2 : SEQ + 256 * (T - GU_PT)) + 64 * wr + fr;
        f32x4 w0[2], w1[2], w2[2], cb[2];
#pragma unroll
        for (int n = 0; n < 2; ++n) { const int f = u.pn * 128 + wc * 32 + 16 * n + 4 * fq;
            w0[n] = *(const f32x4*)(convw + f); w1[n] = *(const f32x4*)(convw + DFF + f); w2[n] = *(const f32x4*)(convw + 2 * DFF + f); cb[n] = *(const f32x4*)(convb + f); }
        float rs[2][4];
#pragma unroll
        for (int ai = 0; ai < 2; ++ai)
#pragma unroll
            for (int m = 0; m < 4; ++m) { const int tok = tok0 + 128 * ai + 16 * m; const bool ok = tok >= 0 && tok < (prompt ? SEQ : MTOK);
                rs[ai][m] = ok ? rsqrtf(sumsq[ok ? tok : 0] * (1.f / DM) + EPS) : 0.f; }
        if (prompt) {
            if (fr >= 14) {
#pragma unroll
                for (int ai = 0; ai < 2; ++ai)
#pragma unroll
                    for (int n = 0; n < 2; ++n) *(LAS f32x4*)(H + ((ai * 2 + wr) * 4 + wc) * 64 + (fr - 14) * 32 + 16 * n + 4 * fq) = acc[ai][0][3][n] * rs[ai][3];
            }
            asm volatile("s_waitcnt lgkmcnt(0)" ::: "memory"); __builtin_amdgcn_s_barrier(); asm volatile("" ::: "memory");
        }
#pragma unroll
        for (int n = 0; n < 2; ++n) {
            const int f = u.pn * 128 + wc * 32 + 16 * n + 4 * fq;
#pragma unroll
            for (int ai = 0; ai < 2; ++ai) {
                f32x4 hm1 = {0.f, 0.f, 0.f, 0.f}, hm2 = {0.f, 0.f, 0.f, 0.f};
                const int sb = 4 * (T - GU_PT) + 2 * ai + wr;
                if (prompt) {
                    if (ai | wr) { const int sai = wr ? ai : ai - 1, swr = wr ^ 1; const LAS float* hp = H + ((sai * 2 + swr) * 4 + wc) * 64 + 16 * n + 4 * fq;
                        hm2 = *(const LAS f32x4*)hp; hm1 = *(const LAS f32x4*)(hp + 32); }
                } else { hm2 = *(const f32x4*)(state + (size_t)(sb * 2) * DFF + f); hm1 = *(const f32x4*)(state + (size_t)(sb * 2 + 1) * DFF + f); }
                f32x4 p1 = hm1, p2;
#pragma unroll
                for (int j = 0; j < 4; ++j) p2[j] = fr == 1 ? hm1[j] : hm2[j];
#pragma unroll
                for (int m = 0; m < 4; ++m) {
                    const f32x4 g = acc[ai][0][m][n] * rs[ai][m];
                    f32x4 gm1, gm2;
#pragma unroll
                    for (int j = 0; j < 4; ++j) {
                        gm1[j] = __int_as_float(__builtin_amdgcn_update_dpp(__float_as_int(p1[j]), __float_as_int(g[j]), 0x111, 0xf, 0xf, false));
                        gm2[j] = __int_as_float(__builtin_amdgcn_update_dpp(__float_as_int(p2[j]), __float_as_int(g[j]), 0x112, 0xf, 0xf, false));
                        if (m < 3) {
                            p1[j] = __int_as_float(__builtin_amdgcn_update_dpp(0, __float_as_int(g[j]), 0x121, 0xf, 0xf, false));
                            p2[j] = __int_as_float(__builtin_amdgcn_update_dpp(0, __float_as_int(g[j]), 0x122, 0xf, 0xf, false)); }
                    }
                    const f32x4 cv = cb[n] + w0[n] * gm2 + w1[n] * gm1 + w2[n] * g;
                    const f32x4 up = acc[ai][1][m][n] * rs[ai][m];
                    f32x4 y;
#pragma unroll
                    for (int j = 0; j < 4; ++j) y[j] = cv[j] * __builtin_amdgcn_rcpf(1.f + __builtin_amdgcn_exp2f(-cv[j] * LOG2E)) * up[j];
                    const int tok = tok0 + 128 * ai + 16 * m;
                    bool ok = true;
                    if (prompt && ai == 0 && m == 0) ok = (64 * wr + fr) >= 2;
                    if (lastT) ok = ok && tok < SEQ;
                    if (ok) *(u32x2*)(Y + ((unsigned)tok * (unsigned)DFF + (unsigned)f)) = pk4(y);
                    if (lastT) { if (tok == SEQ - 2 || tok == SEQ - 1) *(f32x4*)(out + OFF_CVP + (size_t)(tok - (SEQ - 2)) * DFF + f) = g; }
                    if (!prompt && m == 3 && fr >= 14) *(f32x4*)(out + OFF_CVS + (size_t)(sb * 2 + (fr - 14)) * DFF + f) = g;
                }
            }
        }
    }
};

struct EpiDown {
    static constexpr bool PROBE2 = false;
    float* out; const bf16_t* X1B;
    DI void operator()(const AccT& acc, const Unit& u, int wr, int wc, int fr, int fq, LAS unsigned char*) const {
        const int col0 = u.pn * 256 + wc * 32 + 4 * fq;
#pragma unroll
        for (int ai = 0; ai < 2; ++ai)
#pragma unroll
            for (int m = 0; m < 4; ++m) {
                const int row = u.pm * 256 + ai * 128 + wr * 64 + m * 16 + fr;
                float* orow = out + (size_t)row * DM + col0;
                const bf16_t* brow = X1B + (size_t)(row < SEQ ? row + 2 : row + (X1B_PROMPT_ROWS - SEQ)) * DM + col0;
#pragma unroll
                for (int bj = 0; bj < 2; ++bj)
#pragma unroll
                    for (int n = 0; n < 2; ++n) { const int c = bj * 128 + n * 16; const u32x2 xb = *(const u32x2*)(brow + c);
                        const f32x4 xr = {__uint_as_float(xb.x << 16), __uint_as_float(xb.x & 0xffff0000u), __uint_as_float(xb.y << 16), __uint_as_float(xb.y & 0xffff0000u)};
                        *(f32x4*)(orow + c) = xr + acc[ai][bj][m][n]; }
            }
    }
};

#define MFMA32(a, b, c) __builtin_amdgcn_mfma_f32_32x32x16_bf16((a), (b), (c), 0, 0, 0)
DI void kv_dma(const bf16_t* Kg, const bf16_t* Vg, int blk, LAS unsigned char* slot) {
#pragma unroll
    for (int f = 0; f < 4; ++f) __builtin_amdgcn_global_load_lds((const unsigned*)(Kg + (size_t)blk * 2048 + f * 512), (LAS unsigned*)(slot + f * 1024), 16, 0, 0);
#pragma unroll
    for (int f = 0; f < 4; ++f) __builtin_amdgcn_global_load_lds((const unsigned*)(Vg + (size_t)blk * 2048 + f * 512), (LAS unsigned*)(slot + 4096 + f * 1024), 16, 0, 0);
}
template <bool ISB>
DI void attn_block(const LAS unsigned char* slot, const bf16x8 (&qf)[2][4], f32x16 (&o)[2][2], float (&mrun)[2], float (&lrun)[2], int kb, int r, int hh, int lane, const LAS float* biasR, float bconst, int qoff, int nq) {
    bf16x8 kf[4], vf[2][2];
#pragma unroll
    for (int ds = 0; ds < 4; ++ds) kf[ds] = *(const LAS bf16x8*)(slot + ds * 1024 + lane * 16);
#pragma unroll
    for (int db = 0; db < 2; ++db)
#pragma unroll
        for (int t = 0; t < 2; ++t) vf[db][t] = *(const LAS bf16x8*)(slot + 4096 + (db * 2 + t) * 1024 + lane * 16);
#pragma unroll
    for (int qb = 0; qb < 2; ++qb) {
        if (qb >= nq) continue;
        f32x16 s;
#pragma unroll
        for (int i = 0; i < 16; ++i) s[i] = 0.f;
#pragma unroll
        for (int ds = 0; ds < 4; ++ds) s = MFMA32(kf[ds], qf[qb][ds], s);
        float cadd = 0.f;
        if (!ISB) {
            if (kb >= 12) {
                const LAS float* bp = biasR + (191 - (512 + qoff + 32 * qb + r - 32 * kb - 4 * hh));
#pragma unroll
                for (int i = 0; i < 16; ++i) s[i] += bp[8 * (i >> 2) + (i & 3)];
            } else cadd = bconst;
        }
        float mx = fmaxf(fmaxf(s[0], s[1]), s[2]);
#pragma unroll
        for (int i = 3; i < 15; i += 2) mx = fmaxf(fmaxf(mx, s[i]), s[i + 1]);
        mx = fmaxf(mx, s[15]);
        mx = fmaxf(mx, __shfl_xor(mx, 32)) + cadd;
        if (__any(mx > mrun[qb] + 8.f)) {
            const float mnew = fmaxf(mrun[qb], mx), alpha = __builtin_amdgcn_exp2f(mrun[qb] - mnew);
            mrun[qb] = mnew; lrun[qb] *= alpha;
#pragma unroll
            for (int i = 0; i < 16; ++i) { o[qb][0][i] *= alpha; o[qb][1][i] *= alpha; }
        }
        const float c = cadd - mrun[qb];
        float psum = 0.f;
#pragma unroll
        for (int i = 0; i < 16; ++i) { s[i] = __builtin_amdgcn_exp2f(s[i] + c); psum += s[i]; }
        lrun[qb] += psum;
        bf16x8 pf[2];
#pragma unroll
        for (int t = 0; t < 2; ++t) { u32x4 p; p.x = pk2(s[8 * t], s[8 * t + 1]); p.y = pk2(s[8 * t + 2], s[8 * t + 3]); p.z = pk2(s[8 * t + 4], s[8 * t + 5]); p.w = pk2(s[8 * t + 6], s[8 * t + 7]);
            pf[t] = __builtin_bit_cast(bf16x8, p); }
#pragma unroll
        for (int db = 0; db < 2; ++db)
#pragma unroll
            for (int t = 0; t < 2; ++t) o[qb][db] = MFMA32(vf[db][t], pf[t], o[qb][db]);
    }
}
template <bool ISB>
DI void attn_unit(int u, int hq, int qoff, int nq, const bf16_t* Qb, const bf16_t* Kb, const bf16_t* Vtb, bf16_t* O, const float* sinks, const LAS float* biasL, LAS unsigned char* ring, int lane) {
    constexpr int NCH = ISB ? 3 : 9, KROWS = ISB ? KB_ROWS : KA_ROWS;
    const int r = lane & 31, hh = lane >> 5;
    const int hk = ISB ? (hq >> 2) : hq;
    int kbase, j0;
    if (u < 256) { kbase = 64 * (u - (NCH - 1)); j0 = (NCH - 1) - u; if (j0 < 0) j0 = 0; } else { kbase = SEQ + (u - 256) * (64 * NCH); j0 = 0; }
    const bf16_t* Qp = Qb + ((size_t)hq * MTOK + 64 * u + qoff) * 64;
    const bf16_t* Kp = Kb + (size_t)hk * KROWS * 64 + 8 * lane;
    const bf16_t* Vp = Vtb + (size_t)hk * KROWS * 64 + 8 * lane;
    const int kb0 = 2 * j0, kbN = 2 * NCH, blk0 = (kbase >> 5) + kb0, nb = kbN - kb0;
    asm volatile("s_waitcnt vmcnt(0) lgkmcnt(0)" ::: "memory");
    kv_dma(Kp, Vp, blk0, ring);
    kv_dma(Kp, Vp, blk0 + 1, ring + 8192);
    bf16x8 qf[2][4];
#pragma unroll
    for (int qb = 0; qb < 2; ++qb)
#pragma unroll
        for (int ds = 0; ds < 4; ++ds) qf[qb][ds] = *(const bf16x8*)(Qp + (qb < nq ? 32 * qb + r : r) * 64 + 16 * ds + 8 * hh);
    f32x16 o[2][2];
#pragma unroll
    for (int a = 0; a < 2; ++a)
#pragma unroll
        for (int b = 0; b < 2; ++b)
#pragma unroll
            for (int i = 0; i < 16; ++i) o[a][b][i] = 0.f;
    float mrun[2], lrun[2];
#pragma unroll
    for (int a = 0; a < 2; ++a) {
        if (ISB) { mrun[a] = sinks[hq] * LOG2E; lrun[a] = hh ? 0.f : 1.f; }
        else { mrun[a] = -1e30f; lrun[a] = 0.f; } }
    const LAS float* biasR = biasL + hq * 256;
    const float bconst = ISB ? 0.f : biasR[0];
    asm volatile("s_waitcnt vmcnt(0)" ::: "memory");
    for (int ib = 0; ib < nb; ++ib) {
        LAS unsigned char* slot = ring + (ib & 1) * 8192;
        if (ib >= 2) { if (ib + 1 < nb) asm volatile("s_waitcnt vmcnt(8)" ::: "memory"); else asm volatile("s_waitcnt vmcnt(0)" ::: "memory"); }
        attn_block<ISB>(slot, qf, o, mrun, lrun, kb0 + ib, r, hh, lane, biasR, bconst, qoff, nq);
        if (ib + 2 < nb) { asm volatile("s_waitcnt lgkmcnt(0)" ::: "memory"); __builtin_amdgcn_sched_barrier(0); kv_dma(Kp, Vp, blk0 + ib + 2, slot); }
    }
#pragma unroll
    for (int qb = 0; qb < 2; ++qb) {
        if (qb >= nq) continue;
        const float l = lrun[qb] + __shfl_xor(lrun[qb], 32), inv = 1.f / l;
        bf16_t* op = O + (size_t)(64 * u + qoff + 32 * qb + r) * DM + (ISB ? 512 : 0) + hq * 64 + 4 * hh;
#pragma unroll
        for (int db = 0; db < 2; ++db)
#pragma unroll
            for (int i4 = 0; i4 < 4; ++i4) { f32x4 v = {o[qb][db][4 * i4] * inv, o[qb][db][4 * i4 + 1] * inv, o[qb][db][4 * i4 + 2] * inv, o[qb][db][4 * i4 + 3] * inv};
                *(u32x2*)(op + 32 * db + 8 * i4) = pk4(v); }
    }
}

DI float wave_sum(float v) {
#pragma unroll
    for (int o = 1; o < 64; o <<= 1) v += __shfl_xor(v, o);
    return v;
}
DI void transpose_item(const float* W, int ldw, int k0, int n, bf16_t* WT, int Kd, int dst_row, const float* kscale) {
    float v[64];
#pragma unroll
    for (int i = 0; i < 64; ++i) v[i] = W[(size_t)(k0 + i) * ldw + n];
    if (kscale) {
#pragma unroll
        for (int i = 0; i < 64; ++i) v[i] *= kscale[k0 + i];
    }
    bf16_t* d = WT + (size_t)dst_row * Kd + k0;
#pragma unroll
    for (int c = 0; c < 8; ++c) { u32x4 o; o.x = pk2(v[8 * c], v[8 * c + 1]); o.y = pk2(v[8 * c + 2], v[8 * c + 3]); o.z = pk2(v[8 * c + 4], v[8 * c + 5]); o.w = pk2(v[8 * c + 6], v[8 * c + 7]);
        *(u32x4*)(d + 8 * c) = o; }
}
DI void vt_item(const float* src, int past, int nh, int band, int krows, bf16_t* VT, int item, int lane) {
    const int nrb = past / 32, rb = item % nrb, h = (item / nrb) % nh, b = item / (nrb * nh), r0 = rb * 32;
    float v[32];
#pragma unroll
    for (int i = 0; i < 32; ++i) v[i] = src[(((size_t)b * past + r0 + i) * nh + h) * 64 + lane];
    const int krow = SEQ + b * band + r0;
#pragma unroll
    for (int t = 0; t < 2; ++t)
#pragma unroll
        for (int hh = 0; hh < 2; ++hh) { const int k0 = 16 * t + 4 * hh; u32x4 o; o.x = pk2(v[k0], v[k0 + 1]); o.y = pk2(v[k0 + 2], v[k0 + 3]); o.z = pk2(v[k0 + 8], v[k0 + 9]); o.w = pk2(v[k0 + 10], v[k0 + 11]);
            *(u32x4*)(VT + vf_off(h, krows >> 5, krow + k0, lane)) = o; }
}

typedef const __attribute__((address_space(4))) Args* KArgs;
DI void prologue(KArgs ap, int gw, int NGW, int lane) {
    unsigned char* ws = ap->ws;
    const float *xp = ap->in[0], *xs = ap->in[1], *g_attn = ap->in[7], *w_in = ap->in[8];
    { unsigned* z = (unsigned*)(ws + WS_X1B); for (int i = gw * 64 + lane; i < 2 * DM / 2; i += NGW * 64) z[i] = 0u;
      if (gw == 1) { float* gd = (float*)(ws + WS_GAINS); gd[lane] = ap->in[9][lane]; gd[64 + lane] = ap->in[10][lane]; gd[128 + lane] = ap->in[12][lane]; gd[192 + lane] = ap->in[13][lane]; } }
    { float* rt = (float*)(ws + WS_ROPE);
      for (int e = gw * 64 + lane; e < SEQ * 32; e += NGW * 64) { const int pos = e >> 5, i = e & 31;
          const float inv = exp2f(-(float)i * (13.287712379549449f / 32.f));
          double rev = (double)pos * (double)inv * 0.15915494309189535; rev -= __builtin_rint(rev);
          const float fr_ = (float)rev; rt[2 * e] = __builtin_amdgcn_cosf(fr_); rt[2 * e + 1] = __builtin_amdgcn_sinf(fr_); } }
    for (int it = gw; it < 16 * 36; it += NGW) { const int kb = it / 36, hh = it % 36, bj = lane >> 5, x = lane & 31;
        transpose_item(w_in, NIN, 64 * kb, 64 * hh + lane, (bf16_t*)(ws + WS_WIN), DM, 256 * (hh >> 2) + 128 * bj + 32 * (hh & 3) + x, nullptr); }
    {
        f32x4 gg[4];
#pragma unroll
        for (int j = 0; j < 4; ++j) gg[j] = *((const f32x4*)g_attn + lane + 64 * j);
        bf16_t* XN = (bf16_t*)(ws + WS_XN);
        for (int m = gw; m < MTOK; m += NGW) {
            const f32x4* xr = (const f32x4*)(m < SEQ ? xp + (size_t)m * DM : xs + (size_t)(m - SEQ) * DM) + lane;
            f32x4 v[4]; float s = 0.f;
#pragma unroll
            for (int j = 0; j < 4; ++j) { v[j] = xr[64 * j]; s += (v[j][0] * v[j][0] + v[j][1] * v[j][1]) + (v[j][2] * v[j][2] + v[j][3] * v[j][3]); }
            const float rstd = rsqrtf(wave_sum(s) * (1.f / DM) + EPS);
            u32x2* o8 = (u32x2*)(XN + (size_t)m * DM) + lane;
#pragma unroll
            for (int j = 0; j < 4; ++j) o8[64 * j] = pk4(v[j] * rstd * gg[j]);
        }
    }
}
DI void kc_item(const float* src, int past, int nh, int band, int krows, bf16_t* KF, int item, int lane) {
    const int nrb = past / 32, h = item % nh, rb = (item / nh) % nrb, b = item / (nh * nrb), r = lane & 31, hh = lane >> 5;
    const float* sp = src + (((size_t)b * past + rb * 32 + r) * nh + h) * 64 + 8 * hh;
    bf16_t* d = KF + (((size_t)h * (krows >> 5) + ((SEQ + b * band) >> 5) + rb) * 4 * 64 + lane) * 8;
#pragma unroll
    for (int ds = 0; ds < 4; ++ds) { const f32x4 v0 = *(const f32x4*)(sp + 16 * ds), v1 = *(const f32x4*)(sp + 16 * ds + 4);
        u32x4 o; o.x = pk2(v0[0], v0[1]); o.y = pk2(v0[2], v0[3]); o.z = pk2(v1[0], v1[1]); o.w = pk2(v1[2], v1[3]);
        *(u32x4*)(d + ds * 512) = o; }
}
DI void prologue_b(KArgs ap, int gw, int NGW, int lane) {
    unsigned char* ws = ap->ws;
    const float *cak = ap->in[2], *cav = ap->in[3], *cbk = ap->in[4], *cbv = ap->in[5];
    for (int it = gw; it < NSTREAM * 16 * 8; it += NGW) kc_item(cak, 512, 8, 576, KA_ROWS, (bf16_t*)(ws + WS_KA), it, lane);
    for (int it = gw; it < NSTREAM * 4 * 2; it += NGW) kc_item(cbk, 128, 2, 192, KB_ROWS, (bf16_t*)(ws + WS_KB), it, lane);
    for (int it = gw; it < NSTREAM * 8 * 16; it += NGW) vt_item(cav, 512, 8, 576, KA_ROWS, (bf16_t*)(ws + WS_VTA), it, lane);
    for (int it = gw; it < NSTREAM * 2 * 4; it += NGW) vt_item(cbv, 128, 2, 192, KB_ROWS, (bf16_t*)(ws + WS_VTB), it, lane);
}
constexpr int WI_OUT = 16 * 16, WI_GU = 16 * 88, WI_DN = 44 * 16, WI_ALL = WI_OUT + WI_GU + WI_DN;
DI void weight_item(KArgs ap, int it, int lane) {
    unsigned char* ws = ap->ws;
    int r = it;
    if (r < WI_OUT) { const int kb = r / 16, nb = r % 16; transpose_item(ap->in[15], DM, 64 * kb, 64 * nb + lane, (bf16_t*)(ws + WS_WOUT), DM, 64 * nb + lane, nullptr); return; }
    r -= WI_OUT;
    if (r < WI_GU) { const int kb = r / 88, nb = r % 88; const int L = 64 * nb + lane; const int Lp = L < DFF ? L : L - DFF;
        transpose_item(ap->in[17], NGU, 64 * kb, L, (bf16_t*)(ws + WS_WGU), DM, 256 * (Lp >> 7) + (L < DFF ? 0 : 128) + (Lp & 127), ap->in[16]); return; }
    r -= WI_GU;
    { const int kb = r / 16, nb = r % 16; transpose_item(ap->in[20], DM, 64 * kb, 64 * nb + lane, (bf16_t*)(ws + WS_WDN), DFF, 64 * nb + lane, nullptr); }
}

#define XB_TMO      128
#define XB_XCNT(j)  (256  + 64 * (j))
#define XB_XSUB(j)  (1280 + 64 * (j))
#define XB_XGEN(j)  (2304 + 64 * (j))
#define XB_TOP      3328
#define XB_TOPGEN   3392
#define XCD_BAR_WORDS 3456
#define XB_SPIN_CAP (1u << 22)
DI unsigned xb_ld(unsigned* p)              { return __hip_atomic_load(p, __ATOMIC_RELAXED, __HIP_MEMORY_SCOPE_AGENT); }
DI unsigned xb_add(unsigned* p, unsigned v) { return __hip_atomic_fetch_add(p, v, __ATOMIC_RELAXED, __HIP_MEMORY_SCOPE_AGENT); }
DI unsigned xb_xcc_id() { return (unsigned)__builtin_amdgcn_s_getreg((3 << 11) | 20) & 0xFu; }
#define XB_SPIN(cond, bar) do { unsigned _sp = 0; while (cond) { __builtin_amdgcn_s_sleep(1); \
    if ((++_sp & 255u) == 0u) { if (xb_ld(&(bar)[XB_TMO])) break; if (_sp > XB_SPIN_CAP) { atomicAdd(&(bar)[XB_TMO], 1u); break; } } } } while (0)
struct XcdBarrier { unsigned* bar; unsigned x; volatile LAS unsigned* st; };
DI XcdBarrier xcd_barrier_post(unsigned* bar, volatile LAS unsigned* st) {
    XcdBarrier b; b.bar = bar; b.x = xb_xcc_id(); b.st = st;
    if (threadIdx.x == 0) (void)xb_add(&bar[XB_XCNT(b.x)], 1u);
    return b;
}
DI void xcd_barrier_complete(unsigned* bar, unsigned x, unsigned& nloc, unsigned& nx) {
    const unsigned G = gridDim.x * gridDim.y * gridDim.z;
    unsigned sum, cnt, mine, sp = 0u;
    for (;;) {
        sum = 0u; cnt = 0u; mine = 0u;
#pragma unroll
        for (unsigned j = 0; j < 16; ++j) { const unsigned c = xb_ld(&bar[XB_XCNT(j)]); sum += c; cnt += (c > 0u) ? 1u : 0u; mine = (j == x) ? c : mine; }
        if (sum == G) break;
        __builtin_amdgcn_s_sleep(1);
        if ((++sp & 255u) == 0u) { if (xb_ld(&bar[XB_TMO])) break; if (sp > XB_SPIN_CAP) { atomicAdd(&bar[XB_TMO], 1u); break; } }
    }
    nloc = mine > 0u ? mine : 1u; nx = cnt > 0u ? cnt : 1u;
}
DI void xcd_barrier(const XcdBarrier& b) {
    asm volatile("s_waitcnt vmcnt(0)" ::: "memory");
    __syncthreads();
    if (threadIdx.x == 0) {
        unsigned* bar = b.bar;
        __builtin_amdgcn_s_waitcnt(0);
        unsigned nloc = b.st[0], nx = b.st[1];
        if (nloc == 0u) { xcd_barrier_complete(bar, b.x, nloc, nx); b.st[0] = nloc; b.st[1] = nx; }
        const unsigned old = xb_add(&bar[XB_XSUB(b.x)], 1u);
        const unsigned gen = old / nloc;
        if (old + 1u == (gen + 1u) * nloc) {
            __builtin_amdgcn_fence(__ATOMIC_RELEASE, "agent");
            asm volatile("s_waitcnt vmcnt(0)" ::: "memory");
            const unsigned og = xb_add(&bar[XB_TOP], 1u);
            const unsigned tg = og / nx;
            if (og + 1u == (tg + 1u) * nx) xb_add(&bar[XB_TOPGEN], 1u);
            else XB_SPIN(xb_ld(&bar[XB_TOPGEN]) == tg, bar);
            __builtin_amdgcn_fence(__ATOMIC_ACQUIRE, "agent");
            xb_add(&bar[XB_XGEN(b.x)], 1u);
            asm volatile("s_waitcnt vmcnt(0)" ::: "memory");
        } else {
            XB_SPIN(xb_ld(&bar[XB_XGEN(b.x)]) == gen, bar);
            __builtin_amdgcn_fence(__ATOMIC_ACQUIRE, "agent");
            asm volatile("s_waitcnt vmcnt(0)" ::: "memory");
        }
    }
    __syncthreads();
}

__global__ void __launch_bounds__(512, 2) fwd_kernel(Args a_byval) {
    KArgs kp = (KArgs)__builtin_amdgcn_kernarg_segment_ptr();
#define KP() ({ KArgs _p = kp; asm volatile("" : "+s"(_p)); _p; })
    extern __shared__ __attribute__((aligned(16))) unsigned char lds_raw[];
    LAS unsigned char* lds = (LAS unsigned char*)lds_raw;
    const int tid = threadIdx.x, lane = tid & 63, wave = __builtin_amdgcn_readfirstlane(tid >> 6);
    const int G = gridDim.x, bx = blockIdx.x;
    const int lo = kp->ph_lo, hi = kp->ph_hi;
    unsigned char* ws = kp->ws;
#define IN(k) (lo <= (k) && (k) < hi)
#define SEAM(k) do { if (IN(k) && IN((k) + 1)) { for (int _r = 0; _r < 1 + 4 * (NREP(5) - 1); ++_r) xcd_barrier(bar); } } while (0)
    volatile LAS unsigned* MISC = (volatile LAS unsigned*)(lds + RING_BYTES + 8192);
    if (tid < 4) MISC[tid] = 0u;
    __syncthreads();
    XcdBarrier bar; bar.bar = (unsigned*)(ws + WS_BAR); bar.x = 0; bar.st = MISC;
    if (hi - lo > 1 || lo == 3) bar = xcd_barrier_post((unsigned*)(ws + WS_BAR), MISC);
    if (hi > 1000) cg::this_grid().sync();

    if (IN(0)) { for (int rep = 0; rep < NREP(0); ++rep) prologue(KP(), bx * 8 + wave, G * 8, lane); }
    SEAM(0);
    if (IN(1)) {
        pg8::Gemm g{(const bf16_t*)(ws + WS_XN), (const bf16_t*)(ws + WS_WIN), DM};
        pg8::Order<0> S; S.init(MTOK / 256, NIN / 256, G, bx, DM / 64);
        EpiQKV E{(const float*)(ws + WS_GAINS), ws, KP()->out};
        if (NREP(1) == 2) { EpiNull EN; pg8::gemm_phase<EpiNull, pg8::Order<0>, true>(lds, g, S, EN); }
        pg8::gemm_phase<EpiQKV, pg8::Order<0>, true>(lds, g, S, E);
        if (bx >= 136) prologue_b(KP(), (bx - 136) * 8 + wave, (G - 136) * 8, lane);
    }
    SEAM(1);
    if (IN(2)) {
        LAS float* biasL = (LAS float*)(lds + RING_BYTES + 8448);
        { const float* tab = KP()->in[11]; for (int i = tid; i < 8 * 256; i += 512) { const int h = i >> 8, uu = i & 255; int d = 191 - uu; d = d > 128 ? 128 : d; biasL[i] = tab[h * 257 + d + 128] * LOG2E; } }
        const float* sinks = KP()->in[14];
        __syncthreads();
        volatile LAS unsigned* wctr = (volatile LAS unsigned*)(lds + RING_BYTES + 8192 + 64);
        if (tid == 0) *wctr = 0u;
        __syncthreads();
        for (;;) {
            unsigned k = 0; if (lane == 0) k = __hip_atomic_fetch_add((LAS unsigned*)(lds + RING_BYTES + 8192 + 64), 1u, __ATOMIC_RELAXED, __HIP_MEMORY_SCOPE_WORKGROUP);
            k = __builtin_amdgcn_readfirstlane(k);
            if (k >= 19u * NREP(2)) {
                const int it = bx + 256 * (int)(k - 19u * NREP(2));
                if (it >= WI_ALL) break;
                weight_item(KP(), it, lane); continue; }
            if (k >= 19u) k -= 19u;
            if (k < 10u) { const unsigned i = (unsigned)bx + 256u * (k < 8u ? k : 8u); const int nq = k < 8u ? 2 : 1, qoff = k == 9u ? 32 : 0;
                attn_unit<false>(287 - (int)(i >> 3), (int)(i & 7), qoff, nq, (const bf16_t*)(ws + WS_QA), (const bf16_t*)(ws + WS_KA), (const bf16_t*)(ws + WS_VTA), (bf16_t*)(ws + WS_O), nullptr, biasL, lds + wave * 16384, lane); }
            else { const unsigned i = (unsigned)bx + 256u * (k - 10u); attn_unit<true>(287 - (int)(i >> 3), (int)(i & 7), 0, 2, (const bf16_t*)(ws + WS_QB), (const bf16_t*)(ws + WS_KB), (const bf16_t*)(ws + WS_VTB), (bf16_t*)(ws + WS_O), sinks, biasL, lds + wave * 16384, lane); }
        }
        __syncthreads();
    }
    SEAM(2);
    if (IN(3)) {
        const int v = (bx & 7) * 32 + (bx >> 3), x = bx & 7, j = bx >> 3;
#pragma unroll 1
        for (int step = 0; step < 6; ++step) {
            int kind, rs, rstr = 32, rc;
            if (step == 0) { kind = 3; rs = v; rc = 1; }
            else if (step == 1) { kind = 3; rs = 256 + 4 * x + j; rc = j < 4 ? 1 : 0; }
            else if (step == 2) { kind = 4; rs = 88 * x + j; rstr = 28; rc = j < 4 ? 1 : 3; }
            else if (step == 3) { kind = 5; rs = 4 * x + j; rc = j < 4 ? 1 : 0; }
            else if (step == 4) { kind = 4; const int base = 704 + (x < 6 ? 113 * x : 678 + 112 * (x - 6)), r = (x < 6 ? 25 : 24);
                if (j < 4) { rs = base + j; rc = 1; } else { const int jj = j - 4; rs = base + 4 + jj; rstr = 28; rc = 3 + (jj < r ? 1 : 0); } }
            else { kind = 5; rs = 32 + v; rc = 1; }
            if (kind == 3) {
                pg8::Gemm g{(const bf16_t*)(ws + WS_O), (const bf16_t*)(ws + WS_WOUT), DM};
                pg8::RangeOrder<3> S{rs, rstr, rc};
                KArgs q = KP(); EpiOut E{q->in[0], q->in[1], q->out, (bf16_t*)(ws + WS_X1B), (float*)(ws + WS_SUMSQ)};
                if (NREP(8) == 2) { EpiNull EN; pg8::gemm_phase<EpiNull, pg8::RangeOrder<3>, true>(lds, g, S, EN); }
                pg8::gemm_phase<EpiOut, pg8::RangeOrder<3>, true>(lds, g, S, E);
            } else if (kind == 4) {
                pg8::Gemm g{(const bf16_t*)(ws + WS_X1B), (const bf16_t*)(ws + WS_WGU), DM};
                pg8::RangeOrder<4> S{rs, rstr, rc};
                KArgs q = KP(); EpiGU E{(const float*)(ws + WS_SUMSQ), q->in[18], q->in[19], q->in[6], (bf16_t*)(ws + WS_Y), q->out};
#pragma nounroll
                for (int rep = 0; rep < NREP(3); ++rep) pg8::gemm_phase<EpiGU, pg8::RangeOrder<4>, true>(lds, g, S, E);
            } else {
                pg8::Gemm g{(const bf16_t*)(ws + WS_Y), (const bf16_t*)(ws + WS_WDN), DFF};
                pg8::RangeOrder<5> S{rs, rstr, rc};
                EpiDown E{KP()->out, (const bf16_t*)(ws + WS_X1B)};
                if (NREP(9) == 2) { EpiNull EN; pg8::gemm_phase<EpiNull, pg8::RangeOrder<5>, true>(lds, g, S, EN); }
                pg8::gemm_phase<EpiDown, pg8::RangeOrder<5>, true>(lds, g, S, E);
            }
            if (step == 0 || step == 2 || step == 4) xcd_barrier(bar);
        }
    }
#undef IN
#undef SEAM
}

extern "C" void kernel_launch(void* const* d_in, const int* in_sizes, int n_in, void* d_out, int out_size, void* d_ws, size_t ws_size, hipStream_t stream) {
    static int grid = 0;
    if (grid == 0) {
        int dev = 0, cus = 0, per_cu = 0;
        hipGetDevice(&dev);
        hipDeviceGetAttribute(&cus, hipDeviceAttributeMultiprocessorCount, dev);
        if (hipFuncSetAttribute((const void*)fwd_kernel, hipFuncAttributeMaxDynamicSharedMemorySize, LDS_BYTES) != hipSuccess) { fprintf(stderr, "hipFuncSetAttribute failed\n"); grid = -1; return; }
        if (hipOccupancyMaxActiveBlocksPerMultiprocessor(&per_cu, (const void*)fwd_kernel, 512, LDS_BYTES) != hipSuccess || per_cu < 1) { fprintf(stderr, "occupancy query: %d\n", per_cu); per_cu = 1; }
        (void)hipGetLastError();
        grid = 256;
        if (cus != 256) fprintf(stderr, "note: device reports %d CUs; this kernel is laid out for 256\n", cus);
        if (n_in != 21 || ws_size < 256 * MiB) { fprintf(stderr, "unexpected n_in %d / ws %zu\n", n_in, ws_size); grid = -1; return; }
    }
    if (grid < 0) return;
    if (hipMemsetAsync((char*)d_ws + WS_CTL, 0, CTL_ZERO_BYTES, stream) != hipSuccess) { fprintf(stderr, "memset failed\n"); return; }
    Args a{};
    for (int i = 0; i < 21; ++i) a.in[i] = (const float*)d_in[i];
    a.out = (float*)d_out; a.ws = (unsigned char*)d_ws;
#if N_LAUNCH_MODE == 1
    a.ph_lo = 0; a.ph_hi = 4;
    void* args[] = {&a};
    hipError_t e = hipLaunchCooperativeKernel((const void*)fwd_kernel, dim3(grid), dim3(512), args, LDS_BYTES, stream);
    if (e != hipSuccess) fprintf(stderr, "cooperative launch failed: %s (grid %d)\n", hipGetErrorString(e), grid);
#else
    for (int p = 0; p < 4; ++p) { a.ph_lo = p; a.ph_hi = p + 1; hipLaunchKernelGGL(fwd_kernel, dim3(grid), dim3(512), LDS_BYTES, stream, a); }
#endif
}
```
